# Optimizing an MI355X kernel written in HIP

```python
import math
import jax
import jax.numpy as jnp
from jax import lax
import numpy as np

D_MODEL = 1024
BATCH = 8
SEQ = 2048
DEPTH = 1
DEC_BATCH = 8
DEC_SEQ = 4096
PAST_LEN = 128

HEAD_DIM = 64
N_Q_HEADS = 8
N_KV_HEADS = 2
GQA_GROUP = N_Q_HEADS // N_KV_HEADS
ATTN_WIDTH = N_Q_HEADS * HEAD_DIM
KV_WIDTH = N_KV_HEADS * HEAD_DIM
WINDOW = 128
BLOCK = 128
ROPE_DIM = HEAD_DIM // 4
ROPE_THETA = 500000.0
HYENA_WIDTH = D_MODEL // 2
HYENA_ORDER = 2
SHORT_CONV = 3
FILTER_EMB = 33
FILTER_HIDDEN = 64
N_DIRS = 2
FILTER_OUT = N_DIRS * HYENA_ORDER * HYENA_WIDTH
DECAY_PCT_SHORT = 0.3
DECAY_PCT_LONG = 1.5
DECAY_TARGET = 1e-2
DECAY_SHIFT = 0.05
D_FF = 4 * D_MODEL
NORM_EPS = 1e-6
Q_END = ATTN_WIDTH
K_END = Q_END + KV_WIDTH
V_END = K_END + KV_WIDTH
HY_END = V_END + (HYENA_ORDER + 1) * HYENA_WIDTH
IN_PROJ_WIDTH = HY_END + 2 * D_MODEL
NEG_INF = -1e30

kernel_name = 'hybrid_swa_hyena_adaln_encoder'


def rmsnorm(x, g):
    xf = x.astype(jnp.float32)
    y = xf * lax.rsqrt(jnp.mean(xf * xf, axis=-1, keepdims=True) + NORM_EPS)
    return (y * g.astype(jnp.float32)).astype(x.dtype)


def modulate(h, shift, scale):
    return h * (1 + scale[:, None, :]) + shift[:, None, :]


def partial_rope(x):
    L = x.shape[1]
    half = ROPE_DIM // 2
    inv_freq = ROPE_THETA ** (-jnp.arange(half, dtype=jnp.float32) * 2.0 / ROPE_DIM)
    ang = jnp.arange(L, dtype=jnp.float32)[:, None] * inv_freq[None, :]
    cos = jnp.cos(ang)[:, None, :]
    sin = jnp.sin(ang)[:, None, :]
    xr = x[..., :ROPE_DIM].astype(jnp.float32)
    x1, x2 = xr[..., :half], xr[..., half:]
    rot = jnp.concatenate([x1 * cos - x2 * sin, x2 * cos + x1 * sin], axis=-1).astype(x.dtype)
    return jnp.concatenate([rot, x[..., ROPE_DIM:]], axis=-1)


def windowed_gqa_sink(q, k, v, sink):
    B, L = q.shape[0], q.shape[1]
    nb = L // BLOCK
    qb = q.reshape(B, nb, BLOCK, N_KV_HEADS, GQA_GROUP, HEAD_DIM)
    pad = ((0, 0), (BLOCK, BLOCK), (0, 0), (0, 0))

    def bands(t):
        tp = jnp.pad(t, pad).reshape(B, nb + 2, BLOCK, N_KV_HEADS, HEAD_DIM)
        return jnp.concatenate([tp[:, :nb], tp[:, 1:nb + 1], tp[:, 2:nb + 2]], axis=2)

    kb = bands(k)
    vb = bands(v)
    s = jnp.einsum('bnqhgd,bnjhd->bnhgqj', qb, kb,
                   preferred_element_type=jnp.float32) * (HEAD_DIM ** -0.5)
    blk = jnp.arange(nb)[:, None, None]
    qpos = blk * BLOCK + jnp.arange(BLOCK)[None, :, None]
    kpos = (blk - 1) * BLOCK + jnp.arange(3 * BLOCK)[None, None, :]
    valid = (jnp.abs(kpos - qpos) <= WINDOW) & (kpos >= 0) & (kpos < L)
    s = jnp.where(valid[None, :, None, None], s, NEG_INF)
    sk = sink.astype(jnp.float32).reshape(N_KV_HEADS, GQA_GROUP)[None, None, :, :, None, None]
    m = jnp.maximum(jnp.max(s, axis=-1, keepdims=True), sk)
    e = jnp.exp(s - m)
    p = e / (jnp.sum(e, axis=-1, keepdims=True) + jnp.exp(sk - m))
    o = jnp.einsum('bnhgqj,bnjhd->bnqhgd', p.astype(v.dtype), vb)
    return o.reshape(B, L, ATTN_WIDTH)


def hyena_filter_spectra(L, w1, b1, f1, w2, b2, f2, w3):
    f32 = jnp.float32
    t = jnp.linspace(0.0, 1.0, L, dtype=f32)[:, None]
    n_bands = (FILTER_EMB - 1) // 2
    w = 2.0 * math.pi * jnp.arange(L, dtype=f32)[:, None] / L
    fr = jnp.linspace(1e-4, n_bands - 1, n_bands, dtype=f32)[None, :]
    z = jnp.concatenate([t, jnp.cos(fr * w), -jnp.sin(fr * w)], axis=-1)
    h = jnp.sin(f1.astype(f32) * (z @ w1.astype(f32) + b1.astype(f32)))
    h = jnp.sin(f2.astype(f32) * (h @ w2.astype(f32) + b2.astype(f32)))
    h = (h @ w3.astype(f32)).reshape(L, N_DIRS, HYENA_ORDER, HYENA_WIDTH)
    max_decay = math.log(DECAY_TARGET) / DECAY_PCT_SHORT
    min_decay = math.log(DECAY_TARGET) / DECAY_PCT_LONG
    deltas = jnp.abs(jnp.linspace(min_decay, max_decay, HYENA_WIDTH, dtype=f32))
    decay = jnp.exp(-t * deltas[None, :])
    h = h * (decay + DECAY_SHIFT)[:, None, None, :]
    hf, hb = h[:, 0], h[:, 1]
    taps = jnp.concatenate([(hf[0] + hb[0])[None], hf[1:], jnp.zeros_like(hf[:1]), hb[1:][::-1]], axis=0)
    return jnp.fft.rfft(taps, axis=0)


def long_conv(u, spec, bias):
    L = u.shape[1]
    uf = u.astype(jnp.float32)
    y = jnp.fft.irfft(jnp.fft.rfft(uf, n=2 * L, axis=1) * spec[None], n=2 * L, axis=1)[:, :L]
    return y + uf * bias.astype(jnp.float32)


def hyena_branch(u, conv_w, conv_b, spec, hyena_bias):
    L = u.shape[1]
    pad = SHORT_CONV // 2
    up = jnp.pad(u, ((0, 0), (pad, pad), (0, 0)))
    uc = conv_b
    for i in range(SHORT_CONV):
        uc = uc + up[:, i:i + L] * conv_w[i]
    x1, x2, v = jnp.split(uc, HYENA_ORDER + 1, axis=-1)
    z = x1.astype(jnp.float32) * long_conv(v, spec[:, 0], hyena_bias[0])
    z = x2.astype(jnp.float32) * long_conv(z, spec[:, 1], hyena_bias[1])
    return z.astype(u.dtype)


def run_trunk(x, c, w_ada, b_ada, norm1_g, w_in, attn_sink, conv_w, conv_b,
              filt_w1, filt_b1, filt_freq1, filt_w2, filt_b2, filt_freq2, filt_w3,
              hyena_bias, w_attn_o, w_hyena_o, w_out, norm2_g, w_up, w_down,
              w_ada_final, b_ada_final, final_g):
    B, L, _ = x.shape
    c_act = jax.nn.silu(c)
    for l in range(DEPTH):
        mod = c_act @ w_ada[l] + b_ada[l]
        sh1, sc1, g1, sh2, sc2, g2 = jnp.split(mod, 6, axis=-1)
        h = modulate(rmsnorm(x, norm1_g[l]), sh1, sc1)
        proj = h @ w_in[l]
        q = partial_rope(proj[..., :Q_END].reshape(B, L, N_Q_HEADS, HEAD_DIM))
        k = partial_rope(proj[..., Q_END:K_END].reshape(B, L, N_KV_HEADS, HEAD_DIM))
        v = proj[..., K_END:V_END].reshape(B, L, N_KV_HEADS, HEAD_DIM)
        attn = windowed_gqa_sink(q, k, v, attn_sink[l])
        spec = hyena_filter_spectra(L, filt_w1[l], filt_b1[l], filt_freq1[l],
                                    filt_w2[l], filt_b2[l], filt_freq2[l], filt_w3[l])
        hy = hyena_branch(proj[..., V_END:HY_END], conv_w[l], conv_b[l], spec, hyena_bias[l])
        gate_a, gate_h = jnp.split(proj[..., HY_END:], 2, axis=-1)
        merged = (jax.nn.sigmoid(gate_a) * (attn @ w_attn_o[l])
                  + jax.nn.sigmoid(gate_h) * (hy @ w_hyena_o[l]))
        x = x + g1[:, None, :] * (merged @ w_out[l])
        h = modulate(rmsnorm(x, norm2_g[l]), sh2, sc2)
        x = x + g2[:, None, :] * (jnp.square(jax.nn.relu(h @ w_up[l])) @ w_down[l])
    shf, scf = jnp.split(c_act @ w_ada_final + b_ada_final, 2, axis=-1)
    return modulate(rmsnorm(x, final_g), shf, scf)


def setup_inputs(seed: int = 0) -> dict:
    key = jax.random.key(seed)
    ks = jax.random.split(key, 32)

    def nrm(k, shape, scale):
        return jax.random.normal(k, shape, jnp.float32) * scale

    return {
        'x_prompt': nrm(ks[0], (BATCH, SEQ, D_MODEL), 1.0),
        'x_sample': nrm(ks[1], (DEC_BATCH, DEC_SEQ, D_MODEL), 1.0),
        'c_prompt': nrm(ks[2], (BATCH, D_MODEL), 1.0),
        'c_sample': nrm(ks[3], (DEC_BATCH, D_MODEL), 1.0),
        'w_ada': nrm(ks[4], (DEPTH, D_MODEL, 6 * D_MODEL), 0.5 * D_MODEL ** -0.5),
        'b_ada': nrm(ks[5], (DEPTH, 6 * D_MODEL), 0.02),
        'norm1_g': 1.0 + nrm(ks[6], (DEPTH, D_MODEL), 0.05),
        'w_in': nrm(ks[7], (DEPTH, D_MODEL, IN_PROJ_WIDTH), D_MODEL ** -0.5),
        'attn_sink': nrm(ks[8], (DEPTH, N_Q_HEADS), 0.5),
        'conv_w': nrm(ks[9], (DEPTH, SHORT_CONV, (HYENA_ORDER + 1) * HYENA_WIDTH), SHORT_CONV ** -0.5),
        'conv_b': nrm(ks[10], (DEPTH, (HYENA_ORDER + 1) * HYENA_WIDTH), 0.02),
        'filt_w1': nrm(ks[11], (DEPTH, FILTER_EMB, FILTER_HIDDEN), FILTER_EMB ** -0.5),
        'filt_b1': nrm(ks[12], (DEPTH, FILTER_HIDDEN), 0.1),
        'filt_freq1': 1.0 + nrm(ks[13], (DEPTH, FILTER_HIDDEN), 0.05),
        'filt_w2': nrm(ks[14], (DEPTH, FILTER_HIDDEN, FILTER_HIDDEN), FILTER_HIDDEN ** -0.5),
        'filt_b2': nrm(ks[15], (DEPTH, FILTER_HIDDEN), 0.1),
        'filt_freq2': 1.0 + nrm(ks[16], (DEPTH, FILTER_HIDDEN), 0.05),
        'filt_w3': nrm(ks[17], (DEPTH, FILTER_HIDDEN, FILTER_OUT), 0.01),
        'hyena_bias': nrm(ks[18], (DEPTH, HYENA_ORDER, HYENA_WIDTH), 0.1),
        'w_attn_o': nrm(ks[19], (DEPTH, ATTN_WIDTH, D_MODEL), ATTN_WIDTH ** -0.5),
        'w_hyena_o': nrm(ks[20], (DEPTH, HYENA_WIDTH, D_MODEL), HYENA_WIDTH ** -0.5),
        'w_out': nrm(ks[21], (DEPTH, D_MODEL, D_MODEL), D_MODEL ** -0.5),
        'norm2_g': 1.0 + nrm(ks[22], (DEPTH, D_MODEL), 0.05),
        'w_up': nrm(ks[23], (DEPTH, D_MODEL, D_FF), D_MODEL ** -0.5),
        'w_down': nrm(ks[24], (DEPTH, D_FF, D_MODEL), D_FF ** -0.5),
        'w_ada_final': nrm(ks[25], (D_MODEL, 2 * D_MODEL), 0.5 * D_MODEL ** -0.5),
        'b_ada_final': nrm(ks[26], (2 * D_MODEL,), 0.02),
        'final_g': 1.0 + nrm(ks[27], (D_MODEL,), 0.05),
    }


def reference(x_prompt, x_sample, c_prompt, c_sample, w_ada, b_ada, norm1_g, w_in, attn_sink,
              conv_w, conv_b, filt_w1, filt_b1, filt_freq1, filt_w2, filt_b2, filt_freq2, filt_w3,
              hyena_bias, w_attn_o, w_hyena_o, w_out, norm2_g, w_up, w_down,
              w_ada_final, b_ada_final, final_g):
    weights = (w_ada, b_ada, norm1_g, w_in, attn_sink, conv_w, conv_b,
               filt_w1, filt_b1, filt_freq1, filt_w2, filt_b2, filt_freq2, filt_w3,
               hyena_bias, w_attn_o, w_hyena_o, w_out, norm2_g, w_up, w_down,
               w_ada_final, b_ada_final, final_g)
    y_prompt = run_trunk(x_prompt, c_prompt, *weights)
    y_sample = run_trunk(x_sample, c_sample, *weights)
    return (y_prompt, y_sample)
```

```cpp
#include <hip/hip_runtime.h>
#include <hip/hip_cooperative_groups.h>
#include <cstdio>
#include <cstdint>
namespace cg = cooperative_groups;
namespace pg8 {
#define PG8_LAS __attribute__((address_space(3)))
typedef unsigned short bf16_t;
typedef short bf16x8 __attribute__((ext_vector_type(8)));
typedef float f32x4 __attribute__((ext_vector_type(4)));
typedef unsigned u32x4 __attribute__((ext_vector_type(4)));
constexpr int BM = 256, BK = 64, HALF = 128, HTB = HALF * BK * 2  , STAGE_BYTES = 8 * HTB, NXCD = 8, WGM = 8;

__host__ __device__ __forceinline__ int lds_byte(int r, int c) { const int st = (r >> 4) * 2 + (c >> 5), rr = r & 15, cc = c & 31, ob = rr * 64 + cc * 2; return st * 1024 + (ob ^ (((ob >> 9) & 1) << 5)); }
__host__ __device__ __forceinline__ void stage_rc(int b, int& R, int& C) { const int st = b / 1024, sb = b % 1024, swz = sb ^ (((sb >> 9) & 1) << 5); R = (st >> 1) * 16 + swz / 64; C = (st & 1) * 32 + (swz % 64) / 2; }
__host__ __device__ __forceinline__ int perm32(int rho) { const int n = rho >> 4, i = rho & 15; return 8 * (i >> 2) + 4 * n + (i & 3); }

struct Unit { int pm, pn, sel; };
struct Gemm { const bf16_t* A; const bf16_t* Bt; int M, N, K; };

struct StaticOrder {
    int nM, nN, nwg, G, c;
    __host__ __device__ void init(int M, int N, int G_, int c_) { nM = M / BM; nN = N / BM; nwg = nM * nN; G = G_; c = c_; }
    __host__ __device__ bool next(int i, Unit& u) const {
        const long L = (long)i * G + c; if (L >= nwg) return false;
        int wgid = (int)L; { const int q = nwg / NXCD, r = nwg % NXCD, xcd = wgid % NXCD, off = wgid / NXCD; wgid = (xcd < r ? xcd * (q + 1) : r * (q + 1) + (xcd - r) * q) + off; }
        const int nig = WGM * nN, gid = wgid / nig, fm = gid * WGM, gsz = (nM - fm) < WGM ? (nM - fm) : WGM;
        u.pm = fm + ((wgid % nig) % gsz); u.pn = (wgid % nig) / gsz; u.sel = 0; return true;
    }
    __device__ __forceinline__ void a_ready(const Unit&) const {}
    __device__ __forceinline__ void done(const Unit&) const {}
};
struct DualOrder {
    StaticOrder base;
    __host__ __device__ void init(int M, int N, int G_, int c_) { base.init(M, N, G_, c_); }
    __host__ __device__ bool next(int i, Unit& u) const { if (!base.next(i >> 1, u)) return false; u.sel = i & 1; return true; }
    __device__ __forceinline__ void a_ready(const Unit&) const {}
    __device__ __forceinline__ void done(const Unit&) const {}
};
__device__ __forceinline__ unsigned cvt_pk_bf16(float lo, float hi) { unsigned r; asm volatile("v_cvt_pk_bf16_f32 %0, %1, %2" : "=v"(r) : "v"(lo), "v"(hi)); return r; }
template <class Epi, class Sched, bool ALIGN_EPI = false, bool SP2 = false>
__device__ __forceinline__ void gemm_phase(PG8_LAS unsigned char* lds, const Gemm g, const Sched& S, const Epi& E) {
    const int tid = threadIdx.x, wid = __builtin_amdgcn_readfirstlane(tid >> 6), lane = tid & 63, wr = wid >> 2, wc = wid & 3, fr = lane & 15, fq = lane >> 4;
    const int K = g.K, nt = K / BK;
    unsigned voffA[2], voffB[2];
#pragma unroll
    for (int i = 0; i < 2; ++i) { int R, C; stage_rc(tid * 16 + i * 8192, R, C); const int Rb = Epi::PERM ? ((R & ~31) + perm32(R & 31)) : R;
        voffA[i] = (unsigned)(R * K + C) * 2u; voffB[i] = (unsigned)(Rb * K + C) * 2u; }
    const size_t kstep = (size_t)(BK * 2);
    const size_t hstep = (size_t)HALF * K * 2;
    const size_t tstep = 2 * hstep;
    const unsigned ldsw = (unsigned)wid * 1024u;
    const int aoff = lds_byte(wr * 64 + fr, fq * 8), boff = lds_byte(wc * 32 + fr, fq * 8);
#define PG8_SA(b, h) (((b) * 2 + (h)) * HTB)
#define PG8_SB(b, h) ((4 + (b) * 2 + (h)) * HTB)
#define PG8_STAGE(bufoff, gbase, voff) do { _Pragma("unroll") for (int _i = 0; _i < 2; ++_i) \
        __builtin_amdgcn_global_load_lds((const unsigned*)((const char*)(gbase) + (voff)[_i]), (PG8_LAS unsigned*)(lds + (bufoff) + ldsw + _i * 8192), 16, 0, 0); } while (0)
#define PG8_LDA(dst, b, h) do { _Pragma("unroll") for (int m = 0; m < 4; ++m) _Pragma("unroll") for (int k = 0; k < 2; ++k) dst[m][k] = *(const PG8_LAS bf16x8*)(lds + PG8_SA(b, h) + aoff + m * 2048 + k * 1024); } while (0)
#define PG8_LDB(dst, b, h) do { _Pragma("unroll") for (int n = 0; n < 2; ++n) _Pragma("unroll") for (int k = 0; k < 2; ++k) dst[n][k] = *(const PG8_LAS bf16x8*)(lds + PG8_SB(b, h) + boff + n * 2048 + k * 1024); } while (0)
#define PG8_MMA(ai, bj, At, Bt) do { __builtin_amdgcn_s_setprio(1); _Pragma("unroll") for (int m = 0; m < 4; ++m) _Pragma("unroll") for (int n = 0; n < 2; ++n) _Pragma("unroll") for (int k = 0; k < 2; ++k) \
        acc[ai][bj][m][n] = __builtin_amdgcn_mfma_f32_16x16x32_bf16(Bt[n][k], At[m][k], acc[ai][bj][m][n], 0, 0, 0); __builtin_amdgcn_s_setprio(0); } while (0)
#define PG8_WAIT_V(n) asm volatile("s_waitcnt vmcnt(" #n ")" ::: "memory")
#define PG8_WAIT_L(n) asm volatile("s_waitcnt lgkmcnt(" #n ")" ::: "memory")
#define PG8_BAR __builtin_amdgcn_s_barrier()
#define PG8_SCHED __builtin_amdgcn_sched_barrier(0)
    Unit cur, nxt; int ui = 0;
    if (!S.next(0, cur)) return;
    f32x4 acc[2][2][4][2];
#pragma unroll
    for (int a = 0; a < 2; ++a)
#pragma unroll
        for (int b = 0; b < 2; ++b)
#pragma unroll
            for (int m = 0; m < 4; ++m)
#pragma unroll
                for (int n = 0; n < 2; ++n) acc[a][b][m][n] = (f32x4){0.f, 0.f, 0.f, 0.f};
    bf16x8 At[4][2], B0[2][2], B1[2][2];
    const char* cA = (const char*)g.A + (size_t)cur.pm * tstep; const char* cB = (const char*)g.Bt + (size_t)cur.pn * tstep;
    S.a_ready(cur);
    if constexpr (SP2) {
        PG8_STAGE(PG8_SB(0, 0), cB, voffB); PG8_STAGE(PG8_SB(0, 1), cB + hstep, voffB); PG8_STAGE(PG8_SA(0, 0), cA, voffA); PG8_STAGE(PG8_SA(0, 1), cA + hstep, voffA);
        if (wr == 1) PG8_BAR;
        PG8_WAIT_V(2); PG8_BAR;
        PG8_STAGE(PG8_SB(1, 0), cB + kstep, voffB); PG8_STAGE(PG8_SA(1, 0), cA + kstep, voffA); PG8_STAGE(PG8_SB(1, 1), cB + hstep + kstep, voffB);
        PG8_WAIT_V(6); PG8_BAR;
    } else {
        PG8_STAGE(PG8_SB(0, 0), cB, voffB); PG8_STAGE(PG8_SA(0, 0), cA, voffA); PG8_STAGE(PG8_SB(0, 1), cB + hstep, voffB); PG8_STAGE(PG8_SA(0, 1), cA + hstep, voffA);
        if (wr == 1) PG8_BAR;
        PG8_WAIT_V(4); PG8_BAR;
        PG8_STAGE(PG8_SB(1, 0), cB + kstep, voffB); PG8_STAGE(PG8_SA(1, 0), cA + kstep, voffA); PG8_STAGE(PG8_SB(1, 1), cB + hstep + kstep, voffB);
        PG8_WAIT_V(6); PG8_BAR;
    }
    for (;;) {
        const bool has_next = S.next(ui + 1, nxt);
        const char* nA = has_next ? (const char*)g.A + (size_t)nxt.pm * tstep : cA; const char* nB = has_next ? (const char*)g.Bt + (size_t)nxt.pn * tstep : cB;
        for (int t = 0; t < nt; t += 2) {
            const bool last = (t == nt - 2);
            const char* a1 = cA + (size_t)(t + 1) * kstep;
            const char* a2 = last ? nA : cA + (size_t)(t + 2) * kstep; const char* b2 = last ? nB : cB + (size_t)(t + 2) * kstep;
            const char* a3 = a2 + kstep; const char* b3 = b2 + kstep;
            if (last && has_next) S.a_ready(nxt);
            if constexpr (SP2) {
            PG8_LDB(B0, 0, 0); PG8_LDB(B1, 0, 1); PG8_SCHED; PG8_LDA(At, 0, 0); PG8_STAGE(PG8_SA(1, 1), a1 + hstep, voffA);
            PG8_WAIT_V(8); PG8_WAIT_L(0); PG8_BAR; PG8_MMA(0, 0, At, B0); PG8_MMA(0, 1, At, B1); PG8_BAR; PG8_SCHED;
            PG8_LDA(At, 0, 1); PG8_STAGE(PG8_SB(0, 0), b2, voffB); PG8_STAGE(PG8_SB(0, 1), b2 + hstep, voffB); PG8_STAGE(PG8_SA(0, 0), a2, voffA);
            PG8_WAIT_V(8); PG8_WAIT_L(0); PG8_BAR; PG8_MMA(1, 0, At, B0); PG8_MMA(1, 1, At, B1); PG8_BAR; PG8_SCHED;
            PG8_LDB(B0, 1, 0); PG8_LDB(B1, 1, 1); PG8_SCHED; PG8_LDA(At, 1, 0); PG8_STAGE(PG8_SA(0, 1), a2 + hstep, voffA);
            PG8_WAIT_V(8); PG8_WAIT_L(0); PG8_BAR; PG8_MMA(0, 0, At, B0); PG8_MMA(0, 1, At, B1); PG8_BAR; PG8_SCHED;
            PG8_LDA(At, 1, 1); PG8_STAGE(PG8_SB(1, 0), b3, voffB); PG8_STAGE(PG8_SB(1, 1), b3 + hstep, voffB); PG8_STAGE(PG8_SA(1, 0), a3, voffA);
            PG8_WAIT_V(8); PG8_WAIT_L(0); PG8_BAR; PG8_MMA(1, 0, At, B0); PG8_MMA(1, 1, At, B1); PG8_BAR; PG8_SCHED;
            } else {
            PG8_LDB(B0, 0, 0); PG8_SCHED; PG8_LDA(At, 0, 0); PG8_STAGE(PG8_SA(1, 1), a1 + hstep, voffA);
            PG8_WAIT_L(8); PG8_BAR; PG8_WAIT_L(0); PG8_MMA(0, 0, At, B0); PG8_BAR; PG8_SCHED;
            PG8_LDB(B1, 0, 1); PG8_STAGE(PG8_SB(0, 0), b2, voffB);
            PG8_BAR; PG8_WAIT_L(0); PG8_MMA(0, 1, At, B1); PG8_BAR;
            PG8_LDA(At, 0, 1); PG8_STAGE(PG8_SA(0, 0), a2, voffA);
            PG8_BAR; PG8_WAIT_L(0); PG8_MMA(1, 0, At, B0); PG8_BAR; PG8_SCHED;
            PG8_STAGE(PG8_SB(0, 1), b2 + hstep, voffB);
            PG8_WAIT_V(6); PG8_BAR; PG8_MMA(1, 1, At, B1); PG8_BAR;
            PG8_LDB(B0, 1, 0); PG8_SCHED; PG8_LDA(At, 1, 0); PG8_STAGE(PG8_SA(0, 1), a2 + hstep, voffA);
            PG8_WAIT_L(8); PG8_BAR; PG8_WAIT_L(0); PG8_MMA(0, 0, At, B0); PG8_BAR; PG8_SCHED;
            PG8_LDB(B1, 1, 1); PG8_STAGE(PG8_SB(1, 0), b3, voffB);
            PG8_BAR; PG8_WAIT_L(0); PG8_MMA(0, 1, At, B1); PG8_BAR;
            PG8_LDA(At, 1, 1); PG8_STAGE(PG8_SA(1, 0), a3, voffA);
            PG8_BAR; PG8_WAIT_L(0); PG8_MMA(1, 0, At, B0); PG8_BAR; PG8_SCHED;
            PG8_STAGE(PG8_SB(1, 1), b3 + hstep, voffB);
            PG8_WAIT_V(6); PG8_BAR; PG8_MMA(1, 1, At, B1); PG8_BAR;
            }
        }
        if constexpr (ALIGN_EPI) { if (wr == 0) PG8_BAR; }
        if constexpr (!Epi::AFTER_DRAIN) { E(acc, cur, wr, wc, fr, fq); S.done(cur); }
        if (!has_next) break;
#pragma unroll
        for (int a = 0; a < 2; ++a)
#pragma unroll
            for (int b = 0; b < 2; ++b)
#pragma unroll
                for (int m = 0; m < 4; ++m)
#pragma unroll
                    for (int n = 0; n < 2; ++n) acc[a][b][m][n] = (f32x4){0.f, 0.f, 0.f, 0.f};
        cur = nxt; cA = nA; cB = nB; ++ui;
        if constexpr (ALIGN_EPI) { if (wr == 1) PG8_BAR; }
    }
    PG8_WAIT_V(0);
    if constexpr (!ALIGN_EPI) { if (wr == 0) PG8_BAR; }
    PG8_BAR;
    if constexpr (Epi::AFTER_DRAIN) { E.fused(acc, cur, wr, wc, fr, fq, lds, wid, lane); S.done(cur); }
#undef PG8_SA
#undef PG8_SB
#undef PG8_STAGE
#undef PG8_LDA
#undef PG8_LDB
#undef PG8_MMA
#undef PG8_WAIT_V
#undef PG8_WAIT_L
#undef PG8_BAR
#undef PG8_SCHED
}
struct Gemm2 { const bf16_t* A; const bf16_t* Bt; const bf16_t* A2; const bf16_t* Bt2; int M, N, K; };
template <class Epi, class Sched, bool ALIGN_EPI = false, bool SP2 = false>
__device__ __forceinline__ void gemm_phase_dual(PG8_LAS unsigned char* lds, const Gemm2 g, const Sched& S, const Epi& E) {
    const int tid = threadIdx.x, wid = __builtin_amdgcn_readfirstlane(tid >> 6), lane = tid & 63, wr = wid >> 2, wc = wid & 3, fr = lane & 15, fq = lane >> 4;
    const int K = g.K, nt = K / BK;
    unsigned voffA[2], voffB[2];
#pragma unroll
    for (int i = 0; i < 2; ++i) { int R, C; stage_rc(tid * 16 + i * 8192, R, C); const int Rb = Epi::PERM ? ((R & ~31) + perm32(R & 31)) : R;
        voffA[i] = (unsigned)(R * K + C) * 2u; voffB[i] = (unsigned)(Rb * K + C) * 2u; }
    const size_t kstep = (size_t)(BK * 2);
    const size_t hstep = (size_t)HALF * K * 2;
    const size_t tstep = 2 * hstep;
    const unsigned ldsw = (unsigned)wid * 1024u;
    const int aoff = lds_byte(wr * 64 + fr, fq * 8), boff = lds_byte(wc * 32 + fr, fq * 8);
#define PG8_SA(b, h) (((b) * 2 + (h)) * HTB)
#define PG8_SB(b, h) ((4 + (b) * 2 + (h)) * HTB)
#define PG8_STAGE(bufoff, gbase, voff) do { _Pragma("unroll") for (int _i = 0; _i < 2; ++_i) \
        __builtin_amdgcn_global_load_lds((const unsigned*)((const char*)(gbase) + (voff)[_i]), (PG8_LAS unsigned*)(lds + (bufoff) + ldsw + _i * 8192), 16, 0, 0); } while (0)
#define PG8_LDA(dst, b, h) do { _Pragma("unroll") for (int m = 0; m < 4; ++m) _Pragma("unroll") for (int k = 0; k < 2; ++k) dst[m][k] = *(const PG8_LAS bf16x8*)(lds + PG8_SA(b, h) + aoff + m * 2048 + k * 1024); } while (0)
#define PG8_LDB(dst, b, h) do { _Pragma("unroll") for (int n = 0; n < 2; ++n) _Pragma("unroll") for (int k = 0; k < 2; ++k) dst[n][k] = *(const PG8_LAS bf16x8*)(lds + PG8_SB(b, h) + boff + n * 2048 + k * 1024); } while (0)
#define PG8_MMA(ai, bj, At, Bt) do { __builtin_amdgcn_s_setprio(1); _Pragma("unroll") for (int m = 0; m < 4; ++m) _Pragma("unroll") for (int n = 0; n < 2; ++n) _Pragma("unroll") for (int k = 0; k < 2; ++k) \
        acc[ai][bj][m][n] = __builtin_amdgcn_mfma_f32_16x16x32_bf16(Bt[n][k], At[m][k], acc[ai][bj][m][n], 0, 0, 0); __builtin_amdgcn_s_setprio(0); } while (0)
#define PG8_WAIT_V(n) asm volatile("s_waitcnt vmcnt(" #n ")" ::: "memory")
#define PG8_WAIT_L(n) asm volatile("s_waitcnt lgkmcnt(" #n ")" ::: "memory")
#define PG8_BAR __builtin_amdgcn_s_barrier()
#define PG8_SCHED __builtin_amdgcn_sched_barrier(0)
    Unit cur, nxt; int ui = 0;
    if (!S.next(0, cur)) return;
    f32x4 acc[2][2][4][2];
#pragma unroll
    for (int a = 0; a < 2; ++a)
#pragma unroll
        for (int b = 0; b < 2; ++b)
#pragma unroll
            for (int m = 0; m < 4; ++m)
#pragma unroll
                for (int n = 0; n < 2; ++n) acc[a][b][m][n] = (f32x4){0.f, 0.f, 0.f, 0.f};
    bf16x8 At[4][2], B0[2][2], B1[2][2];
    const char* cA = (const char*)(cur.sel ? g.A2 : g.A) + (size_t)cur.pm * tstep; const char* cB = (const char*)(cur.sel ? g.Bt2 : g.Bt) + (size_t)cur.pn * tstep;
    S.a_ready(cur);
    if constexpr (SP2) {
        PG8_STAGE(PG8_SB(0, 0), cB, voffB); PG8_STAGE(PG8_SB(0, 1), cB + hstep, voffB); PG8_STAGE(PG8_SA(0, 0), cA, voffA); PG8_STAGE(PG8_SA(0, 1), cA + hstep, voffA);
        if (wr == 1) PG8_BAR;
        PG8_WAIT_V(2); PG8_BAR;
        PG8_STAGE(PG8_SB(1, 0), cB + kstep, voffB); PG8_STAGE(PG8_SA(1, 0), cA + kstep, voffA); PG8_STAGE(PG8_SB(1, 1), cB + hstep + kstep, voffB);
        PG8_WAIT_V(6); PG8_BAR;
    } else {
        PG8_STAGE(PG8_SB(0, 0), cB, voffB); PG8_STAGE(PG8_SA(0, 0), cA, voffA); PG8_STAGE(PG8_SB(0, 1), cB + hstep, voffB); PG8_STAGE(PG8_SA(0, 1), cA + hstep, voffA);
        if (wr == 1) PG8_BAR;
        PG8_WAIT_V(4); PG8_BAR;
        PG8_STAGE(PG8_SB(1, 0), cB + kstep, voffB); PG8_STAGE(PG8_SA(1, 0), cA + kstep, voffA); PG8_STAGE(PG8_SB(1, 1), cB + hstep + kstep, voffB);
        PG8_WAIT_V(6); PG8_BAR;
    }
    for (;;) {
        const bool has_next = S.next(ui + 1, nxt);
        const char* nA = has_next ? (const char*)(nxt.sel ? g.A2 : g.A) + (size_t)nxt.pm * tstep : cA; const char* nB = has_next ? (const char*)(nxt.sel ? g.Bt2 : g.Bt) + (size_t)nxt.pn * tstep : cB;
        for (int t = 0; t < nt; t += 2) {
            const bool last = (t == nt - 2);
            const char* a1 = cA + (size_t)(t + 1) * kstep;
            const char* a2 = last ? nA : cA + (size_t)(t + 2) * kstep; const char* b2 = last ? nB : cB + (size_t)(t + 2) * kstep;
            const char* a3 = a2 + kstep; const char* b3 = b2 + kstep;
            if (last && has_next) S.a_ready(nxt);
            if constexpr (SP2) {
            PG8_LDB(B0, 0, 0); PG8_LDB(B1, 0, 1); PG8_SCHED; PG8_LDA(At, 0, 0); PG8_STAGE(PG8_SA(1, 1), a1 + hstep, voffA);
            PG8_WAIT_V(8); PG8_WAIT_L(0); PG8_BAR; PG8_MMA(0, 0, At, B0); PG8_MMA(0, 1, At, B1); PG8_BAR; PG8_SCHED;
            PG8_LDA(At, 0, 1); PG8_STAGE(PG8_SB(0, 0), b2, voffB); PG8_STAGE(PG8_SB(0, 1), b2 + hstep, voffB); PG8_STAGE(PG8_SA(0, 0), a2, voffA);
            PG8_WAIT_V(8); PG8_WAIT_L(0); PG8_BAR; PG8_MMA(1, 0, At, B0); PG8_MMA(1, 1, At, B1); PG8_BAR; PG8_SCHED;
            PG8_LDB(B0, 1, 0); PG8_LDB(B1, 1, 1); PG8_SCHED; PG8_LDA(At, 1, 0); PG8_STAGE(PG8_SA(0, 1), a2 + hstep, voffA);
            PG8_WAIT_V(8); PG8_WAIT_L(0); PG8_BAR; PG8_MMA(0, 0, At, B0); PG8_MMA(0, 1, At, B1); PG8_BAR; PG8_SCHED;
            PG8_LDA(At, 1, 1); PG8_STAGE(PG8_SB(1, 0), b3, voffB); PG8_STAGE(PG8_SB(1, 1), b3 + hstep, voffB); PG8_STAGE(PG8_SA(1, 0), a3, voffA);
            PG8_WAIT_V(8); PG8_WAIT_L(0); PG8_BAR; PG8_MMA(1, 0, At, B0); PG8_MMA(1, 1, At, B1); PG8_BAR; PG8_SCHED;
            } else {
            PG8_LDB(B0, 0, 0); PG8_SCHED; PG8_LDA(At, 0, 0); PG8_STAGE(PG8_SA(1, 1), a1 + hstep, voffA);
            PG8_WAIT_L(8); PG8_BAR; PG8_WAIT_L(0); PG8_MMA(0, 0, At, B0); PG8_BAR; PG8_SCHED;
            PG8_LDB(B1, 0, 1); PG8_STAGE(PG8_SB(0, 0), b2, voffB);
            PG8_BAR; PG8_WAIT_L(0); PG8_MMA(0, 1, At, B1); PG8_BAR;
            PG8_LDA(At, 0, 1); PG8_STAGE(PG8_SA(0, 0), a2, voffA);
            PG8_BAR; PG8_WAIT_L(0); PG8_MMA(1, 0, At, B0); PG8_BAR; PG8_SCHED;
            PG8_STAGE(PG8_SB(0, 1), b2 + hstep, voffB);
            PG8_WAIT_V(6); PG8_BAR; PG8_MMA(1, 1, At, B1); PG8_BAR;
            PG8_LDB(B0, 1, 0); PG8_SCHED; PG8_LDA(At, 1, 0); PG8_STAGE(PG8_SA(0, 1), a2 + hstep, voffA);
            PG8_WAIT_L(8); PG8_BAR; PG8_WAIT_L(0); PG8_MMA(0, 0, At, B0); PG8_BAR; PG8_SCHED;
            PG8_LDB(B1, 1, 1); PG8_STAGE(PG8_SB(1, 0), b3, voffB);
            PG8_BAR; PG8_WAIT_L(0); PG8_MMA(0, 1, At, B1); PG8_BAR;
            PG8_LDA(At, 1, 1); PG8_STAGE(PG8_SA(1, 0), a3, voffA);
            PG8_BAR; PG8_WAIT_L(0); PG8_MMA(1, 0, At, B0); PG8_BAR; PG8_SCHED;
            PG8_STAGE(PG8_SB(1, 1), b3 + hstep, voffB);
            PG8_WAIT_V(6); PG8_BAR; PG8_MMA(1, 1, At, B1); PG8_BAR;
            }
        }
        if constexpr (ALIGN_EPI) { if (wr == 0) PG8_BAR; }
        if (cur.sel == 0) E.mid(acc, cur, wr, wc, fr, fq); else E(acc, cur, wr, wc, fr, fq);
        if (!has_next) break;
        if (cur.sel == 1)
#pragma unroll
        for (int a = 0; a < 2; ++a)
#pragma unroll
            for (int b = 0; b < 2; ++b)
#pragma unroll
                for (int m = 0; m < 4; ++m)
#pragma unroll
                    for (int n = 0; n < 2; ++n) acc[a][b][m][n] = (f32x4){0.f, 0.f, 0.f, 0.f};
        cur = nxt; cA = nA; cB = nB; ++ui;
        if constexpr (ALIGN_EPI) { if (wr == 1) PG8_BAR; }
    }
    PG8_WAIT_V(0);
    if constexpr (!ALIGN_EPI) { if (wr == 0) PG8_BAR; }
    PG8_BAR;
#undef PG8_SA
#undef PG8_SB
#undef PG8_STAGE
#undef PG8_LDA
#undef PG8_LDB
#undef PG8_MMA
#undef PG8_WAIT_V
#undef PG8_WAIT_L
#undef PG8_BAR
#undef PG8_SCHED
}
}

#define GAS __attribute__((address_space(1)))
#define LAS __attribute__((address_space(3)))
typedef unsigned short bf16;
typedef float f32x4 __attribute__((ext_vector_type(4)));
typedef float f32x2 __attribute__((ext_vector_type(2)));
typedef float f32x16 __attribute__((ext_vector_type(16)));
typedef unsigned u32x4 __attribute__((ext_vector_type(4)));
typedef unsigned u32x2 __attribute__((ext_vector_type(2)));
typedef short bf16x8 __attribute__((ext_vector_type(8)));
typedef short bf16x4 __attribute__((ext_vector_type(4)));

constexpr int DM = 1024, MP = 16384, MS = 32768, MT = MP + MS, LP = 2048, LS = 4096;
constexpr int NPROJ = 4352, FF = 4096, HW = 512, NMOD = 8192;
constexpr int NWAVES = 8, NTHR = 512;
constexpr int LDS_BYTES = 147456;
constexpr float LOG2E = 1.4426950408889634f;
constexpr float QSCALE = 0.125f * LOG2E;
constexpr float INV2PI = 0.15915494309189535f;

constexpr size_t MiB = 1u << 20;
constexpr size_t WS_MOD = 0;
constexpr size_t WS_BAR = MiB / 2;
constexpr size_t WS_HFP = MiB / 2;
constexpr size_t WS_TWA = MiB;
constexpr size_t WS_HFS = MiB;
constexpr size_t WS_WIN = 2 * MiB;
constexpr size_t WS_WAO = WS_WIN + 17 * MiB / 2;
constexpr size_t WS_WHO = WS_WAO + MiB;
constexpr size_t WS_WOUT = WS_WHO + MiB;
constexpr size_t WS_WUP = WS_WOUT + 2 * MiB;
constexpr size_t WS_WDN = WS_WUP + 8 * MiB;
constexpr size_t WS_H = WS_WDN + 8 * MiB;
constexpr size_t WS_R = WS_H + 96 * MiB;
constexpr size_t WS_Q = WS_R;
constexpr size_t WS_K = WS_Q + 48 * MiB;
constexpr size_t WS_VT = WS_K + 12 * MiB;
constexpr size_t WS_UT = WS_VT + 12 * MiB;
constexpr size_t WS_ATT = WS_UT + 144 * MiB;
constexpr size_t WS_HY = WS_ATT + 48 * MiB;
constexpr size_t WS_HYT = WS_HY + 48 * MiB;
constexpr size_t WS_TAPS = WS_HYT + 48 * MiB;
constexpr size_t WS_UP = WS_R;
constexpr size_t WS_END = WS_R + 384 * MiB;
static_assert(WS_TAPS + 24 * MiB <= WS_END && WS_END <= 512 * MiB, "ws map");

__device__ __forceinline__ unsigned f2bf(float f) { unsigned u = __builtin_bit_cast(unsigned, f); return (u + 0x7fffu + ((u >> 16) & 1u)) >> 16; }
typedef __bf16 bf16x2_t __attribute__((ext_vector_type(2)));
__device__ __forceinline__ unsigned pk2(float lo, float hi) { const f32x2 v = {lo, hi}; const bf16x2_t b = __builtin_convertvector(v, bf16x2_t); return __builtin_bit_cast(unsigned, b); }
__device__ __forceinline__ float bf2f(unsigned h) { return __builtin_bit_cast(float, h << 16); }
__device__ __forceinline__ float bflo(unsigned w) { return __builtin_bit_cast(float, w << 16); }
__device__ __forceinline__ float bfhi(unsigned w) { return __builtin_bit_cast(float, w & 0xffff0000u); }
__device__ __forceinline__ float sin_rev(float r) { r -= floorf(r); return __builtin_amdgcn_sinf(r); }
__device__ __forceinline__ float cos_rev(float r) { r -= floorf(r); return __builtin_amdgcn_cosf(r); }
__device__ __forceinline__ float wave_sum(float v) {
#pragma unroll
    for (int o = 1; o < 64; o <<= 1) v += __shfl_xor(v, o);
    return v;
}
__device__ __forceinline__ f32x2 cmul(f32x2 a, f32x2 b) { return (f32x2){a.x * b.x - a.y * b.y, a.x * b.y + a.y * b.x}; }

struct Args {
    const float* in[28];
    float* out; unsigned char* ws;
    int ph_lo, ph_hi;
};
enum { I_XP = 0, I_XS, I_CP, I_CS, I_WADA, I_BADA, I_N1G, I_WIN, I_SINK, I_CONVW, I_CONVB, I_FW1, I_FB1, I_FF1, I_FW2, I_FB2, I_FF2, I_FW3,
       I_HBIAS, I_WAO, I_WHO, I_WOUT, I_N2G, I_WUP, I_WDN, I_WADAF, I_BADAF, I_FING };

__device__ __forceinline__ int row_batch(int r) { return r < MP ? (r >> 11) : 8 + ((r - MP) >> 12); }

__device__ __forceinline__ void p0_transpose_item(const float* W, int K, int N, bf16* WT, LAS float* scr, int item, int lane) {
    const int nblk = N / 32, kb = item / nblk, nb = item % nblk, k0 = 64 * kb, n0 = 32 * nb;
#pragma unroll 8
    for (int i = 0; i < 32; ++i) { const int kk = 2 * i + (lane >> 5); scr[kk * 33 + (lane & 31)] = W[(size_t)(k0 + kk) * N + n0 + (lane & 31)]; }
    asm volatile("s_waitcnt lgkmcnt(0)" ::: "memory");
    const int c = lane & 7;
#pragma unroll
    for (int j = 0; j < 4; ++j) { const int n = (lane >> 3) + 8 * j; const LAS float* s = scr + (8 * c) * 33 + n;
        u32x4 o; o.x = pk2(s[0 * 33], s[1 * 33]); o.y = pk2(s[2 * 33], s[3 * 33]); o.z = pk2(s[4 * 33], s[5 * 33]); o.w = pk2(s[6 * 33], s[7 * 33]);
        *(u32x4*)(WT + (size_t)(n0 + n) * K + k0 + 8 * c) = o; }
    asm volatile("s_waitcnt lgkmcnt(0)" ::: "memory");
}

__device__ __forceinline__ void p0_prologue(const Args& a, LAS unsigned char* lds, int tid, int lane, int wave) {
    unsigned char* ws = a.ws;
    {
        LAS float* cact = (LAS float*)lds;
        LAS float* red = (LAS float*)(lds + 65536);
        for (int i = tid; i < 16 * 1024; i += NTHR) { const int g = i >> 10, k = i & 1023; const float c = g < 8 ? a.in[I_CP][g * 1024 + k] : a.in[I_CS][(g - 8) * 1024 + k];
            cact[i] = c / (1.f + __expf(-c)); }
        __syncthreads();
        float* modall = (float*)(ws + WS_MOD);
        for (int item = blockIdx.x; item < NMOD / 32; item += gridDim.x) {
            const int cl = tid & 31, kg = tid >> 5, col = item * 32 + cl;
            const float* W; int ldw, cc; float bias;
            if (col < 6144) { W = a.in[I_WADA]; ldw = 6144; cc = col; bias = a.in[I_BADA][cc]; } else { W = a.in[I_WADAF]; ldw = 2048; cc = col - 6144; bias = a.in[I_BADAF][cc]; }
            float acc[16];
#pragma unroll
            for (int g = 0; g < 16; ++g) acc[g] = 0.f;
#pragma unroll 8
            for (int kk = 0; kk < 64; ++kk) { const int k = kg * 64 + kk; const float w = W[(size_t)k * ldw + cc];
#pragma unroll
                for (int g = 0; g < 16; ++g) acc[g] += cact[g * 1024 + k] * w; }
#pragma unroll
            for (int g = 0; g < 16; ++g) red[(kg * 16 + g) * 32 + cl] = acc[g];
            __syncthreads();
            { const int g = tid >> 5; float s = bias;
#pragma unroll
              for (int k2 = 0; k2 < 16; ++k2) s += red[(k2 * 16 + g) * 32 + cl];
              modall[g * NMOD + col] = s; }
            __syncthreads();
        }
    }
    {
        LAS float* scr = (LAS float*)(lds + wave * 16384);
        const int gw = blockIdx.x * NWAVES + wave, NGW = gridDim.x * NWAVES;
        constexpr int I_1 = (DM / 64) * (NPROJ / 32), I_2 = (HW / 64) * (DM / 32), I_3 = I_2, I_4 = (DM / 64) * (DM / 32), I_5 = (DM / 64) * (FF / 32), I_6 = (FF / 64) * (DM / 32);
        constexpr int NITEMS = I_1 + I_2 + I_3 + I_4 + I_5 + I_6;
        for (int it = gw; it < NITEMS; it += NGW) {
            int r = it;
            if (r < I_1) { p0_transpose_item(a.in[I_WIN], DM, NPROJ, (bf16*)(ws + WS_WIN), scr, r, lane); continue; } r -= I_1;
            if (r < I_2) { p0_transpose_item(a.in[I_WAO], HW, DM, (bf16*)(ws + WS_WAO), scr, r, lane); continue; } r -= I_2;
            if (r < I_3) { p0_transpose_item(a.in[I_WHO], HW, DM, (bf16*)(ws + WS_WHO), scr, r, lane); continue; } r -= I_3;
            if (r < I_4) { p0_transpose_item(a.in[I_WOUT], DM, DM, (bf16*)(ws + WS_WOUT), scr, r, lane); continue; } r -= I_4;
            if (r < I_5) { p0_transpose_item(a.in[I_WUP], DM, FF, (bf16*)(ws + WS_WUP), scr, r, lane); continue; } r -= I_5;
            p0_transpose_item(a.in[I_WDN], FF, DM, (bf16*)(ws + WS_WDN), scr, r, lane);
        }
        const float* w1 = a.in[I_FW1]; const float* w2 = a.in[I_FW2];
        const float b1 = a.in[I_FB1][lane], f1 = a.in[I_FF1][lane], b2 = a.in[I_FB2][lane], f2 = a.in[I_FF2][lane];
        for (int pidx = gw; pidx < LP + LS; pidx += NGW) {
            const int L = pidx < LP ? LP : LS, n = pidx < LP ? pidx : pidx - LP;
            float zval = 0.f;
            if (lane == 0) zval = (float)n / (float)(L - 1);
            else if (lane <= 32) { const int i = (lane - 1) & 15; const float fr = 1e-4f + (float)i * ((15.f - 1e-4f) / 15.f);
                const float rev = fr * ((float)n / (float)L);
                zval = lane <= 16 ? cos_rev(rev) : -sin_rev(rev); }
            float pre = b1;
            for (int i = 0; i < 33; ++i) pre += __shfl(zval, i) * w1[i * 64 + lane];
            const float h1 = sin_rev(f1 * pre * INV2PI);
            pre = b2;
            for (int i = 0; i < 64; ++i) pre += __shfl(h1, i) * w2[i * 64 + lane];
            const float h2 = sin_rev(f2 * pre * INV2PI);
            bf16* hb = (bf16*)a.out + (size_t)pidx * 256;
            hb[lane] = (bf16)f2bf(h2); hb[lane + 64] = 0; hb[lane + 128] = 0; hb[lane + 192] = 0;
        }
        for (int idx = blockIdx.x * NTHR + tid; idx < 15 * 256; idx += gridDim.x * NTHR) { const int r = idx / 256 + 1, pos = idx & 255;
            const float rev = (float)((r * pos) & 4095) * (1.f / 4096.f);
            ((f32x2*)(ws + WS_TWA))[idx] = (f32x2){__builtin_amdgcn_cosf(rev), -__builtin_amdgcn_sinf(rev)}; }
        {
            bf16* w3t = (bf16*)a.out + (size_t)(LP + LS) * 256;
            for (int idx = blockIdx.x * NTHR + tid; idx < 2048 * 256; idx += gridDim.x * NTHR) { const int col = idx >> 8, jj = idx & 255;
                w3t[idx] = jj < 64 ? (bf16)f2bf(a.in[I_FW3][(size_t)jj * 2048 + col]) : (bf16)0; }
        }
    }
}

template <bool OUTF32, bool SRCBF = false>
__device__ __forceinline__ void norm_rows(const Args& a, const float* src0  , const float* g, int off_sh, int off_sc, void* dst, int lane, int wave) {
    const float* modall = (const float*)(a.ws + WS_MOD);
    const int gw = blockIdx.x * NWAVES + wave, NGW = gridDim.x * NWAVES;
    constexpr int NR = 4;
    f32x4 gg[4];
#pragma unroll
    for (int j = 0; j < 4; ++j) gg[j] = ((const f32x4*)g)[lane + 64 * j];
#pragma unroll 1
    for (int gi = gw; gi < MT / NR; gi += NGW) {
        const int m0 = gi * NR;
        f32x4 v[NR][4]; float ss[NR];
#pragma unroll
        for (int r = 0; r < NR; ++r) { const int m = m0 + r;
            if (SRCBF) {
#pragma unroll
                for (int j = 0; j < 4; ++j) { const u32x2 q = ((const u32x2*)((const bf16*)src0 + (size_t)m * DM))[lane + 64 * j]; v[r][j] = (f32x4){bflo(q.x), bfhi(q.x), bflo(q.y), bfhi(q.y)}; }
            } else {
                const float* x = src0 ? src0 + (size_t)m * DM : (m < MP ? a.in[I_XP] + (size_t)m * DM : a.in[I_XS] + (size_t)(m - MP) * DM);
#pragma unroll
                for (int j = 0; j < 4; ++j) v[r][j] = ((const f32x4*)x)[lane + 64 * j];
            } }
        const int b = row_batch(m0); const float* sh = modall + b * NMOD + off_sh; const float* sc = modall + b * NMOD + off_sc;
        f32x4 scv[4], shv[4];
#pragma unroll
        for (int j = 0; j < 4; ++j) { scv[j] = ((const f32x4*)sc)[lane + 64 * j]; shv[j] = ((const f32x4*)sh)[lane + 64 * j]; }
#pragma unroll
        for (int r = 0; r < NR; ++r) { float s = 0.f;
#pragma unroll
            for (int j = 0; j < 4; ++j) s += (v[r][j].x * v[r][j].x + v[r][j].y * v[r][j].y) + (v[r][j].z * v[r][j].z + v[r][j].w * v[r][j].w);
            ss[r] = 1.f / sqrtf(wave_sum(s) * (1.f / DM) + 1e-6f); }
#pragma unroll
        for (int r = 0; r < NR; ++r) { const int m = m0 + r;
#pragma unroll
            for (int j = 0; j < 4; ++j) {
                const f32x4 o = v[r][j] * ss[r] * gg[j] * (scv[j] + 1.f) + shv[j];
                if (OUTF32) ((f32x4*)dst)[(size_t)m * 256 + lane + 64 * j] = o;
                else ((u32x2*)dst)[(size_t)m * 256 + lane + 64 * j] = (u32x2){pk2(o.x, o.y), pk2(o.z, o.w)};
            } }
    }
}

__device__ __forceinline__ void quad_transpose(float (&v)[4], int lane) {
    const bool hi2 = lane & 2, odd = lane & 1;
    { const float s0 = hi2 ? v[0] : v[2], s1 = hi2 ? v[1] : v[3];
      const float r0 = __builtin_bit_cast(float, __builtin_amdgcn_update_dpp(0, __builtin_bit_cast(int, s0), 0x4E, 0xF, 0xF, false));
      const float r1 = __builtin_bit_cast(float, __builtin_amdgcn_update_dpp(0, __builtin_bit_cast(int, s1), 0x4E, 0xF, 0xF, false));
      if (hi2) { v[0] = r0; v[1] = r1; } else { v[2] = r0; v[3] = r1; } }
    { const float s0 = odd ? v[0] : v[1], s1 = odd ? v[2] : v[3];
      const float r0 = __builtin_bit_cast(float, __builtin_amdgcn_update_dpp(0, __builtin_bit_cast(int, s0), 0xB1, 0xF, 0xF, false));
      const float r1 = __builtin_bit_cast(float, __builtin_amdgcn_update_dpp(0, __builtin_bit_cast(int, s1), 0xB1, 0xF, 0xF, false));
      if (odd) { v[0] = r0; v[2] = r1; } else { v[1] = r0; v[3] = r1; } }
}
__device__ __forceinline__ void store_tr8(bf16* base  , int L, int pos, const f32x4& a0, const f32x4& a1, int lane) {
    float v0[4] = {a0[0], a0[1], a0[2], a0[3]}, v1[4] = {a1[0], a1[1], a1[2], a1[3]};
    quad_transpose(v0, lane); quad_transpose(v1, lane);
    const int q = lane & 3, p4 = pos & ~3;
    *(u32x2*)(base + (size_t)q * L + p4) = (u32x2){pk2(v0[0], v0[1]), pk2(v0[2], v0[3])};
    *(u32x2*)(base + (size_t)(4 + q) * L + p4) = (u32x2){pk2(v1[0], v1[1]), pk2(v1[2], v1[3])};
}
struct EpiProj {
    static constexpr bool PERM = true, AFTER_DRAIN = false;
    bf16 *Q, *Kb, *VT, *UT, *G;
    __device__ __forceinline__ void operator()(const f32x4 (&acc)[2][2][4][2], const pg8::Unit& u, int wr, int wc, int fr, int fq) const {
        const int trow = u.pm * 256, pn = u.pn;
        int L, brow0;
        if (trow < MP) { L = LP; brow0 = trow & ~(LP - 1); } else { L = LS; brow0 = MP + ((trow - MP) & ~(LS - 1)); }
        const int rbase = trow + wr * 64 + fr;
        const int cw = wc * 32 + 8 * fq;
        if (pn <= 2) {
#pragma unroll
            for (int bj = 0; bj < 2; ++bj) {
                if (pn == 2 && bj == 1) {
                    bf16* vt = VT + (size_t)brow0 * 128;
#pragma unroll
                    for (int ai = 0; ai < 2; ++ai)
#pragma unroll
                        for (int m = 0; m < 4; ++m) { const int pos = rbase + ai * 128 + m * 16 - brow0;
                            store_tr8(vt + (size_t)cw * L, L, pos, acc[ai][bj][m][0], acc[ai][bj][m][1], fr); }
                } else {
                    const bool isq = pn < 2;
                    const bool roped = ((wc & 1) == 0) && (fq < 2);
                    const float scl = isq ? QSCALE : 1.f;
#pragma unroll
                    for (int ai = 0; ai < 2; ++ai)
#pragma unroll
                        for (int m = 0; m < 4; ++m) { const int row = rbase + ai * 128 + m * 16; const float pos = (float)(row - brow0);
                            float v[8];
#pragma unroll
                            for (int n = 0; n < 2; ++n)
#pragma unroll
                                for (int r = 0; r < 4; ++r) v[4 * n + r] = acc[ai][bj][m][n][r];
                            if ((wc & 1) == 0) {
#pragma unroll
                                for (int i = 0; i < 8; ++i) {
                                    const float other = __shfl_xor(v[i], 16);
                                    constexpr float IF[8] = {1.0f, 0.19393820f, 0.037612028f, 0.0072944090f, 0.0014146648f, 0.00027435756f, 0.000053208356f, 0.000010319133f};
                                    const float ang = pos * IF[i]; const float rev = ang * INV2PI;
                                    const float cs = cos_rev(rev), sn = sin_rev(rev);
                                    const float rot = fq == 0 ? v[i] * cs - other * sn : v[i] * cs + other * sn;
                                    v[i] = roped ? rot : v[i];
                                }
                            }
                            u32x4 w; w.x = pk2(v[0] * scl, v[1] * scl); w.y = pk2(v[2] * scl, v[3] * scl); w.z = pk2(v[4] * scl, v[5] * scl); w.w = pk2(v[6] * scl, v[7] * scl);
                            if (isq) *(u32x4*)(Q + (size_t)row * 512 + pn * 256 + bj * 128 + cw) = w;
                            else *(u32x4*)(Kb + (size_t)row * 128 + cw) = w; }
                }
            }
        } else if (pn < 9) {
            bf16* ut = UT + (size_t)brow0 * 1536;
            const int ch0 = (pn - 3) * 256 + cw;
#pragma unroll
            for (int bj = 0; bj < 2; ++bj)
#pragma unroll
                for (int ai = 0; ai < 2; ++ai)
#pragma unroll
                    for (int m = 0; m < 4; ++m) { const int pos = rbase + ai * 128 + m * 16 - brow0;
                        store_tr8(ut + (size_t)(ch0 + bj * 128) * L, L, pos, acc[ai][bj][m][0], acc[ai][bj][m][1], fr); }
        } else {
            const int c0 = (pn - 9) * 256 + cw;
#pragma unroll
            for (int ai = 0; ai < 2; ++ai)
#pragma unroll
                for (int m = 0; m < 4; ++m) { const int row = rbase + ai * 128 + m * 16;
#pragma unroll
                    for (int bj = 0; bj < 2; ++bj) { float v[8];
#pragma unroll
                        for (int n = 0; n < 2; ++n)
#pragma unroll
                            for (int r = 0; r < 4; ++r) v[4 * n + r] = __builtin_amdgcn_rcpf(1.f + __builtin_amdgcn_exp2f(-LOG2E * acc[ai][bj][m][n][r]));
                        u32x4 w; w.x = pk2(v[0], v[1]); w.y = pk2(v[2], v[3]); w.z = pk2(v[4], v[5]); w.w = pk2(v[6], v[7]);
                        *(u32x4*)(G + (size_t)row * 2048 + c0 + bj * 128) = w; } }
        }
    }
};

struct EpiTaps {
    static constexpr bool PERM = true, AFTER_DRAIN = false;
    unsigned short* T;
    __device__ __forceinline__ unsigned h2(float a, float b) const { return (unsigned)__builtin_bit_cast(unsigned short, (_Float16)a) | ((unsigned)__builtin_bit_cast(unsigned short, (_Float16)b) << 16); }
    __device__ __forceinline__ void operator()(const f32x4 (&acc)[2][2][4][2], const pg8::Unit& u, int wr, int wc, int fr, int fq) const {
        const float mind = -3.0701134573253944f, maxd = -15.350567286626972f;
        const int pbase = u.pn * 256 + wc * 32 + 8 * fq;
        const int L = pbase < LP ? LP : LS; const float nl = -LOG2E / (float)(L - 1);
        const int nb = pbase < LP ? pbase : pbase - LP;
#pragma unroll
        for (int ai = 0; ai < 2; ++ai)
#pragma unroll
            for (int m = 0; m < 4; ++m) { const int row = u.pm * 256 + ai * 128 + wr * 64 + m * 16 + fr; const int c = row & 511;
                const float dl = fabsf(mind + (float)c * ((maxd - mind) / 511.f)) * nl;
#pragma unroll
                for (int bj = 0; bj < 2; ++bj) { const float t0 = (float)(nb + bj * 128);
                    const f32x4 v0 = acc[ai][bj][m][0], v1 = acc[ai][bj][m][1];
                    u32x4 w;
                    w.x = h2(v0[0] * (__builtin_amdgcn_exp2f(t0 * dl) + 0.05f), v0[1] * (__builtin_amdgcn_exp2f((t0 + 1.f) * dl) + 0.05f));
                    w.y = h2(v0[2] * (__builtin_amdgcn_exp2f((t0 + 2.f) * dl) + 0.05f), v0[3] * (__builtin_amdgcn_exp2f((t0 + 3.f) * dl) + 0.05f));
                    w.z = h2(v1[0] * (__builtin_amdgcn_exp2f((t0 + 4.f) * dl) + 0.05f), v1[1] * (__builtin_amdgcn_exp2f((t0 + 5.f) * dl) + 0.05f));
                    w.w = h2(v1[2] * (__builtin_amdgcn_exp2f((t0 + 6.f) * dl) + 0.05f), v1[3] * (__builtin_amdgcn_exp2f((t0 + 7.f) * dl) + 0.05f));
                    *(u32x4*)(T + (size_t)row * (LP + LS) + pbase + bj * 128) = w; } }
    }
};

#ifndef EPI2_LO
#define EPI2_LO 0
#define EPI2_HI 16
#endif
struct EpiTwice { static constexpr bool PERM = true, AFTER_DRAIN = false; EpiProj e;
    __device__ __forceinline__ void operator()(const f32x4 (&acc)[2][2][4][2], const pg8::Unit& u, int wr, int wc, int fr, int fq) const { e(acc, u, wr, wc, fr, fq); asm volatile("" ::: "memory"); if (u.pn >= EPI2_LO && u.pn <= EPI2_HI) e(acc, u, wr, wc, fr, fq); } };

struct EpiMerge {
    static constexpr bool PERM = true, AFTER_DRAIN = false;
    bf16* O; const bf16* gate;
    __device__ __forceinline__ void mid(f32x4 (&acc)[2][2][4][2], const pg8::Unit& u, int wr, int wc, int fr, int fq) const {
        const int rbase = u.pm * 256 + wr * 64 + fr, cbase = u.pn * 256 + wc * 32 + 8 * fq;
#pragma unroll
        for (int ai = 0; ai < 2; ++ai)
#pragma unroll
            for (int m = 0; m < 4; ++m) { const int row = rbase + ai * 128 + m * 16;
#pragma unroll
                for (int bj = 0; bj < 2; ++bj) { const int col = cbase + bj * 128;
                    const u32x4 ga = *(const u32x4*)(gate + (size_t)row * 2048 + col), gh = *(const u32x4*)(gate + (size_t)row * 2048 + 1024 + col);
                    f32x4& v0 = acc[ai][bj][m][0]; f32x4& v1 = acc[ai][bj][m][1];
                    v0[0] *= bflo(ga.x) * __builtin_amdgcn_rcpf(bflo(gh.x)); v0[1] *= bfhi(ga.x) * __builtin_amdgcn_rcpf(bfhi(gh.x));
                    v0[2] *= bflo(ga.y) * __builtin_amdgcn_rcpf(bflo(gh.y)); v0[3] *= bfhi(ga.y) * __builtin_amdgcn_rcpf(bfhi(gh.y));
                    v1[0] *= bflo(ga.z) * __builtin_amdgcn_rcpf(bflo(gh.z)); v1[1] *= bfhi(ga.z) * __builtin_amdgcn_rcpf(bfhi(gh.z));
                    v1[2] *= bflo(ga.w) * __builtin_amdgcn_rcpf(bflo(gh.w)); v1[3] *= bfhi(ga.w) * __builtin_amdgcn_rcpf(bfhi(gh.w)); } }
    }
    __device__ __forceinline__ void operator()(const f32x4 (&acc)[2][2][4][2], const pg8::Unit& u, int wr, int wc, int fr, int fq) const {
        const int rbase = u.pm * 256 + wr * 64 + fr, cbase = u.pn * 256 + wc * 32 + 8 * fq;
#pragma unroll
        for (int ai = 0; ai < 2; ++ai) {
            u32x4 ghv[4][2];
#pragma unroll
            for (int m = 0; m < 4; ++m)
#pragma unroll
                for (int bj = 0; bj < 2; ++bj) ghv[m][bj] = *(const u32x4*)(gate + (size_t)(rbase + ai * 128 + m * 16) * 2048 + 1024 + cbase + bj * 128);
#pragma unroll
            for (int m = 0; m < 4; ++m) { const int row = rbase + ai * 128 + m * 16;
#pragma unroll
                for (int bj = 0; bj < 2; ++bj) { const int col = cbase + bj * 128;
                    const u32x4 gh = ghv[m][bj];
                    const f32x4 v0 = acc[ai][bj][m][0], v1 = acc[ai][bj][m][1];
                    u32x4 w; w.x = pk2(v0[0] * bflo(gh.x), v0[1] * bfhi(gh.x)); w.y = pk2(v0[2] * bflo(gh.y), v0[3] * bfhi(gh.y));
                    w.z = pk2(v1[0] * bflo(gh.z), v1[1] * bfhi(gh.z)); w.w = pk2(v1[2] * bflo(gh.w), v1[3] * bfhi(gh.w));
                    *(u32x4*)(O + (size_t)row * 1024 + col) = w; } } }
    }
};

template <int MODE> struct EpiGen {
    static constexpr bool PERM = true, AFTER_DRAIN = false;
    bf16* O; const bf16* gate; int goff; float* OUT; const float* R; const float* xp; const float* xs; const float* modall; int moff;
    __device__ __forceinline__ void operator()(const f32x4 (&acc)[2][2][4][2], const pg8::Unit& u, int wr, int wc, int fr, int fq) const {
        const int trow = u.pm * 256;
        const int rbase = trow + wr * 64 + fr;
        const int cbase = u.pn * 256 + wc * 32 + 8 * fq;
        const int b = row_batch(trow);
        if (MODE == 2 || MODE == 4) {
            f32x4 gm[2][2];
#pragma unroll
            for (int bj = 0; bj < 2; ++bj) { const int col = cbase + bj * 128; gm[bj][0] = *(const f32x4*)(modall + b * NMOD + moff + col); gm[bj][1] = *(const f32x4*)(modall + b * NMOD + moff + col + 4); }
#pragma unroll
            for (int ai = 0; ai < 2; ++ai) {
                f32x4 r0[4][2], r1[4][2];
#pragma unroll
                for (int m = 0; m < 4; ++m)
#pragma unroll
                    for (int bj = 0; bj < 2; ++bj) { const int row = rbase + ai * 128 + m * 16, col = cbase + bj * 128;
                        if (MODE == 4) { const u32x4 xb = *(const u32x4*)((const bf16*)R + (size_t)row * DM + col);
                            r0[m][bj] = (f32x4){bflo(xb.x), bfhi(xb.x), bflo(xb.y), bfhi(xb.y)}; r1[m][bj] = (f32x4){bflo(xb.z), bfhi(xb.z), bflo(xb.w), bfhi(xb.w)}; }
                        else if (trow < MP) { const float* rr = xp + (size_t)row * DM + col; r0[m][bj] = ((const f32x4*)rr)[0]; r1[m][bj] = ((const f32x4*)rr)[1]; }
                        else { const float* rr = xs + (size_t)(row - MP) * DM + col; r0[m][bj] = ((const f32x4*)rr)[0]; r1[m][bj] = ((const f32x4*)rr)[1]; } }
#pragma unroll
                for (int m = 0; m < 4; ++m)
#pragma unroll
                    for (int bj = 0; bj < 2; ++bj) { const int row = rbase + ai * 128 + m * 16, col = cbase + bj * 128;
                        const f32x4 o0 = r0[m][bj] + gm[bj][0] * acc[ai][bj][m][0], o1 = r1[m][bj] + gm[bj][1] * acc[ai][bj][m][1];
                        *(u32x4*)((bf16*)OUT + (size_t)row * DM + col) = (u32x4){pk2(o0[0], o0[1]), pk2(o0[2], o0[3]), pk2(o1[0], o1[1]), pk2(o1[2], o1[3])}; }
            }
            return;
        }
#pragma unroll
        for (int ai = 0; ai < 2; ++ai)
#pragma unroll
            for (int m = 0; m < 4; ++m) { const int row = rbase + ai * 128 + m * 16;
#pragma unroll
                for (int bj = 0; bj < 2; ++bj) { const int col = cbase + bj * 128;
                    const f32x4 v0 = acc[ai][bj][m][0], v1 = acc[ai][bj][m][1];
                    if (MODE == 0 || MODE == 1) {
                        const u32x4 gw = *(const u32x4*)(gate + (size_t)row * 2048 + goff + col);
                        float o[8] = {v0[0] * bflo(gw.x), v0[1] * bfhi(gw.x), v0[2] * bflo(gw.y), v0[3] * bfhi(gw.y), v1[0] * bflo(gw.z), v1[1] * bfhi(gw.z), v1[2] * bflo(gw.w), v1[3] * bfhi(gw.w)};
                        u32x4* dst = (u32x4*)(O + (size_t)row * 1024 + col);
                        if (MODE == 1) { const u32x4 t = *dst; o[0] += bflo(t.x); o[1] += bfhi(t.x); o[2] += bflo(t.y); o[3] += bfhi(t.y); o[4] += bflo(t.z); o[5] += bfhi(t.z); o[6] += bflo(t.w); o[7] += bfhi(t.w); }
                        u32x4 w; w.x = pk2(o[0], o[1]); w.y = pk2(o[2], o[3]); w.z = pk2(o[4], o[5]); w.w = pk2(o[6], o[7]);
                        *dst = w;
                    } else if (MODE == 2 || MODE == 4) {
                        f32x4 r0, r1;
                        if (MODE == 4) { const u32x4 xb = *(const u32x4*)((const bf16*)R + (size_t)row * DM + col);
                            r0 = (f32x4){bflo(xb.x), bfhi(xb.x), bflo(xb.y), bfhi(xb.y)}; r1 = (f32x4){bflo(xb.z), bfhi(xb.z), bflo(xb.w), bfhi(xb.w)}; }
                        else if (trow < MP) { const float* rr = xp + (size_t)row * DM + col; r0 = ((const f32x4*)rr)[0]; r1 = ((const f32x4*)rr)[1]; }
                        else { const float* rr = xs + (size_t)(row - MP) * DM + col; r0 = ((const f32x4*)rr)[0]; r1 = ((const f32x4*)rr)[1]; }
                        const f32x4 g0 = *(const f32x4*)(modall + b * NMOD + moff + col), g1 = *(const f32x4*)(modall + b * NMOD + moff + col + 4);
                        const f32x4 o0 = r0 + g0 * v0, o1 = r1 + g1 * v1;
                        *(u32x4*)((bf16*)OUT + (size_t)row * DM + col) = (u32x4){pk2(o0[0], o0[1]), pk2(o0[2], o0[3]), pk2(o1[0], o1[1]), pk2(o1[2], o1[3])};
                    } else {
                        float o[8];
#pragma unroll
                        for (int r = 0; r < 4; ++r) { const float a0 = fmaxf(v0[r], 0.f), a1 = fmaxf(v1[r], 0.f); o[r] = a0 * a0; o[4 + r] = a1 * a1; }
                        u32x4 w; w.x = pk2(o[0], o[1]); w.y = pk2(o[2], o[3]); w.z = pk2(o[4], o[5]); w.w = pk2(o[6], o[7]);
                        __builtin_nontemporal_store(w, (u32x4*)(O + (size_t)row * FF + col));
                    } } }
    }
};

constexpr int AT_KS = 0, AT_KROW = 144, AT_VS = 384 * AT_KROW, AT_VROW = 776;
__device__ __forceinline__ void attn_unit(const Args& a, int unit, LAS unsigned char* lds, int tid, int lane, int wave) {
    const bf16* Q = (const bf16*)(a.ws + WS_Q); const bf16* Kb = (const bf16*)(a.ws + WS_K); const bf16* VT = (const bf16*)(a.ws + WS_VT); bf16* ATT = (bf16*)(a.ws + WS_ATT);
    int L, brow0, qb, kvh;
    if (unit < 256) { L = LP; const int b = unit >> 5, rem = unit & 31; qb = rem >> 1; kvh = rem & 1; brow0 = b * LP; }
    else { const int u2 = unit - 256; L = LS; const int b = u2 >> 6, rem = u2 & 63; qb = rem >> 1; kvh = rem & 1; brow0 = MP + b * LS; }
    const int nqb = L >> 7;
    bf16x8 qfa[2][4];
    {
        const int c_ = lane & 31, hi_ = lane >> 5;
#pragma unroll
        for (int s = 0; s < 2; ++s) { const int task = wave * 2 + s, g = task >> 2, qt = task & 3, head = kvh * 4 + g;
            const bf16* qrow = Q + (size_t)(brow0 + qb * 128 + qt * 32 + c_) * 512 + head * 64 + hi_ * 8;
#pragma unroll
            for (int ks = 0; ks < 4; ++ks) qfa[s][ks] = *(const bf16x8*)(qrow + ks * 16); }
    }
    {
        int tv = tid; asm volatile("" : "+v"(tv));
        u32x4 pk[6], pv[6];
#pragma unroll
        for (int i = 0; i < 6; ++i) { const int ch = tv + NTHR * i, kr = ch >> 3, c8 = ch & 7; const int kpos = (qb - 1) * 128 + kr;
            pk[i] = (u32x4){0u, 0u, 0u, 0u};
            if (kpos >= 0 && kpos < L) pk[i] = *(const u32x4*)(Kb + (size_t)(brow0 + kpos) * 128 + kvh * 64 + c8 * 8); }
#pragma unroll
        for (int i = 0; i < 6; ++i) { const int ch = tv + NTHR * i, d = ch / 48, c16 = ch - d * 48; const int kpos0 = (qb - 1) * 128 + c16 * 8;
            pv[i] = (u32x4){0u, 0u, 0u, 0u};
            if (kpos0 >= 0 && kpos0 < L) pv[i] = *(const u32x4*)(VT + (size_t)brow0 * 128 + (size_t)(kvh * 64 + d) * L + kpos0); }
#pragma unroll
        for (int i = 0; i < 6; ++i) { const int ch = tv + NTHR * i, kr = ch >> 3, c8 = ch & 7; *(LAS u32x4*)(lds + AT_KS + kr * AT_KROW + c8 * 16) = pk[i]; }
#pragma unroll
        for (int i = 0; i < 6; ++i) { const int ch = tv + NTHR * i, d = ch / 48, c16 = ch - d * 48;
            LAS u32x2* dst = (LAS u32x2*)(lds + AT_VS + d * AT_VROW + c16 * 16);
            dst[0] = (u32x2){pv[i].x, pv[i].y}; dst[1] = (u32x2){pv[i].z, pv[i].w}; }
    }
    __syncthreads();
    const int c = lane & 31, hi = lane >> 5;
    for (int s = 0; s < 2; ++s) {
        const int task = wave * 2 + s, g = task >> 2, qt = task & 3, head = kvh * 4 + g;
        const int qrel = qt * 32 + c;
        bf16x8 qf[4];
#pragma unroll
        for (int ks = 0; ks < 4; ++ks) qf[ks] = s == 0 ? qfa[0][ks] : qfa[1][ks];
        float m_run = a.in[I_SINK][head] * LOG2E, l_run = hi == 0 ? 1.f : 0.f;
        f32x16 o0 = {}, o1 = {};
        for (int kb = 0; kb < 3; ++kb) {
            if ((qb == 0 && kb == 0) || (qb == nqb - 1 && kb == 2)) continue;
            f32x16 sc[4];
#define TILE_ON(kt) ((4 * kb + (kt)) >= qt && (4 * kb + (kt)) <= qt + 8)
#pragma unroll
            for (int kt = 0; kt < 4; ++kt) { sc[kt] = (f32x16){};
                if (!TILE_ON(kt)) continue;
#pragma unroll
                for (int ks = 0; ks < 4; ++ks) { const bf16x8 kf = *(const LAS bf16x8*)(lds + AT_KS + (kb * 128 + kt * 32 + c) * AT_KROW + ks * 32 + hi * 16);
                    sc[kt] = __builtin_amdgcn_mfma_f32_32x32x16_bf16(kf, qf[ks], sc[kt], 0, 0, 0); } }
            float mx = -1e30f;
#pragma unroll
            for (int kt = 0; kt < 4; ++kt) { if (!TILE_ON(kt)) continue;
#pragma unroll
                for (int i = 0; i < 16; ++i) { const int krel = (kb - 1) * 128 + kt * 32 + 8 * (i >> 2) + 4 * hi + (i & 3);
                    const int d = krel - qrel; const bool ok = (d <= 128) && (d >= -128);
                    sc[kt][i] = ok ? sc[kt][i] : -1e30f; mx = fmaxf(mx, sc[kt][i]); } }
            mx = fmaxf(mx, __shfl_xor(mx, 32));
            const float m_new = fmaxf(m_run, mx), alpha = __builtin_amdgcn_exp2f(m_run - m_new);
            m_run = m_new;
            float ls = 0.f;
#pragma unroll
            for (int kt = 0; kt < 4; ++kt) { if (!TILE_ON(kt)) continue;
#pragma unroll
                for (int i = 0; i < 16; ++i) { const float p = __builtin_amdgcn_exp2f(sc[kt][i] - m_new); sc[kt][i] = p; ls += p; } }
            l_run = l_run * alpha + ls;
            o0 = o0 * alpha; o1 = o1 * alpha;
#pragma unroll
            for (int kt = 0; kt < 4; ++kt) { if (!TILE_ON(kt)) continue;
#pragma unroll
                for (int hA = 0; hA < 2; ++hA) {
                    bf16x8 pb; { const u32x4 w = (u32x4){pk2(sc[kt][8 * hA + 0], sc[kt][8 * hA + 1]), pk2(sc[kt][8 * hA + 2], sc[kt][8 * hA + 3]), pk2(sc[kt][8 * hA + 4], sc[kt][8 * hA + 5]), pk2(sc[kt][8 * hA + 6], sc[kt][8 * hA + 7])};
                        pb = __builtin_bit_cast(bf16x8, w); }
                    const int kidx = kb * 128 + kt * 32 + 16 * hA + 4 * hi;
                    { const LAS u32x2* vp = (const LAS u32x2*)(lds + AT_VS + c * AT_VROW + kidx * 2); const u32x2 x0 = vp[0], x1 = vp[2];
                      const bf16x8 vf = __builtin_bit_cast(bf16x8, (u32x4){x0.x, x0.y, x1.x, x1.y});
                      o0 = __builtin_amdgcn_mfma_f32_32x32x16_bf16(vf, pb, o0, 0, 0, 0); }
                    { const LAS u32x2* vp = (const LAS u32x2*)(lds + AT_VS + (32 + c) * AT_VROW + kidx * 2); const u32x2 x0 = vp[0], x1 = vp[2];
                      const bf16x8 vf = __builtin_bit_cast(bf16x8, (u32x4){x0.x, x0.y, x1.x, x1.y});
                      o1 = __builtin_amdgcn_mfma_f32_32x32x16_bf16(vf, pb, o1, 0, 0, 0); }
                } }
#undef TILE_ON
        }
        const float inv = 1.f / (l_run + __shfl_xor(l_run, 32));
        bf16* orow = ATT + (size_t)(brow0 + qb * 128 + qrel) * 512 + head * 64 + 4 * hi;
#pragma unroll
        for (int ig = 0; ig < 4; ++ig) {
            *(u32x2*)(orow + 8 * ig) = (u32x2){pk2(o0[4 * ig] * inv, o0[4 * ig + 1] * inv), pk2(o0[4 * ig + 2] * inv, o0[4 * ig + 3] * inv)};
            *(u32x2*)(orow + 32 + 8 * ig) = (u32x2){pk2(o1[4 * ig] * inv, o1[4 * ig + 1] * inv), pk2(o1[4 * ig + 2] * inv, o1[4 * ig + 3] * inv)};
        }
    }
    __syncthreads();
}

constexpr int BLK = 4352;
__device__ __forceinline__ int phi(int i) { return i + (i >> 4); }
__device__ __forceinline__ f32x2 mulw16(f32x2 a, int k, bool cj) {
    constexpr float C1 = 0.92387953251128674f, S1 = 0.38268343236508977f, R2 = 0.70710678118654752f;
    k &= 15;
    if (k == 0) return a;
    if (k == 8) return -a;
    if (k == 4) return cj ? (f32x2){-a.y, a.x} : (f32x2){a.y, -a.x};
    if (k == 12) return cj ? (f32x2){a.y, -a.x} : (f32x2){-a.y, a.x};
    float cs, sn;
    switch (k) { case 1: cs = C1; sn = S1; break; case 2: cs = R2; sn = R2; break; case 3: cs = S1; sn = C1; break; case 5: cs = -S1; sn = C1; break;
                 case 6: cs = -R2; sn = R2; break; case 7: cs = -C1; sn = S1; break; case 9: cs = -C1; sn = -S1; break; case 10: cs = -R2; sn = -R2; break;
                 case 11: cs = -S1; sn = -C1; break; case 13: cs = S1; sn = -C1; break; case 14: cs = R2; sn = -R2; break; default: cs = C1; sn = -S1; break; }
    const float wy = cj ? sn : -sn;
    return (f32x2){a.x * cs - a.y * wy, a.x * wy + a.y * cs};
}
template <bool INV> __device__ __forceinline__ void dft16(f32x2 (&a)[16]) {
    if (!INV) {
#pragma unroll
        for (int k = 0; k < 8; ++k) { const f32x2 u = a[k], v = a[k + 8]; a[k] = u + v; a[k + 8] = mulw16(u - v, k, false); }
#pragma unroll
        for (int h = 0; h < 16; h += 8)
#pragma unroll
            for (int k = 0; k < 4; ++k) { const f32x2 u = a[h + k], v = a[h + k + 4]; a[h + k] = u + v; a[h + k + 4] = mulw16(u - v, 2 * k, false); }
#pragma unroll
        for (int h = 0; h < 16; h += 4)
#pragma unroll
            for (int k = 0; k < 2; ++k) { const f32x2 u = a[h + k], v = a[h + k + 2]; a[h + k] = u + v; a[h + k + 2] = mulw16(u - v, 4 * k, false); }
#pragma unroll
        for (int h = 0; h < 16; h += 2) { const f32x2 u = a[h], v = a[h + 1]; a[h] = u + v; a[h + 1] = u - v; }
    } else {
#pragma unroll
        for (int h = 0; h < 16; h += 2) { const f32x2 u = a[h], v = a[h + 1]; a[h] = u + v; a[h + 1] = u - v; }
#pragma unroll
        for (int h = 0; h < 16; h += 4)
#pragma unroll
            for (int k = 0; k < 2; ++k) { const f32x2 u = a[h + k], v = mulw16(a[h + k + 2], 4 * k, true); a[h + k] = u + v; a[h + k + 2] = u - v; }
#pragma unroll
        for (int h = 0; h < 16; h += 8)
#pragma unroll
            for (int k = 0; k < 4; ++k) { const f32x2 u = a[h + k], v = mulw16(a[h + k + 4], 2 * k, true); a[h + k] = u + v; a[h + k + 4] = u - v; }
#pragma unroll
        for (int k = 0; k < 8; ++k) { const f32x2 u = a[k], v = mulw16(a[k + 8], k, true); a[k] = u + v; a[k + 8] = u - v; }
    }
}
template <bool INV, bool TW> __device__ __forceinline__ void r16_pass(LAS f32x2* Xb, int base, int stride, float rev) {
    f32x2 a[16];
#pragma unroll
    for (int k = 0; k < 16; ++k) a[k] = Xb[base + k * stride];
    constexpr int BR4[16] = {0, 8, 4, 12, 2, 10, 6, 14, 1, 9, 5, 13, 3, 11, 7, 15};
    f32x2 t1 = (f32x2){1.f, 0.f};
    if (TW) {
        asm volatile("" : "+v"(rev));
        const float cs = __builtin_amdgcn_cosf(rev), sn = __builtin_amdgcn_sinf(rev);
        t1 = (f32x2){cs, INV ? sn : -sn};
    }
    if (INV && TW) { f32x2 tr = t1;
#pragma unroll
        for (int r = 1; r < 16; ++r) { a[BR4[r]] = cmul(a[BR4[r]], tr); if (r < 15) tr = cmul(tr, t1); } }
    dft16<INV>(a);
    if (!INV && TW) { f32x2 tr = t1;
#pragma unroll
        for (int r = 1; r < 16; ++r) { a[BR4[r]] = cmul(a[BR4[r]], tr); if (r < 15) tr = cmul(tr, t1); } }
#pragma unroll
    for (int k = 0; k < 16; ++k) Xb[base + k * stride] = a[k];
}
template <bool INV> __device__ __forceinline__ void fft4096(LAS f32x2* Xb, int j, bool active) {
    if (!INV) {
        if (active) r16_pass<false, true>(Xb, phi(j), 272, (float)j * (1.f / 4096.f));
        __syncthreads();
        if (active) r16_pass<false, true>(Xb, (j >> 4) * 272 + (j & 15), 17, (float)(j & 15) * (1.f / 256.f));
        __syncthreads();
        if (active) r16_pass<false, false>(Xb, 17 * j, 1, 0.f);
        __syncthreads();
    } else {
        if (active) r16_pass<true, false>(Xb, 17 * j, 1, 0.f);
        __syncthreads();
        if (active) r16_pass<true, true>(Xb, (j >> 4) * 272 + (j & 15), 17, (float)(j & 15) * (1.f / 256.f));
        __syncthreads();
        if (active) r16_pass<true, true>(Xb, phi(j), 272, (float)j * (1.f / 4096.f));
        __syncthreads();
    }
}
template <bool SAMPLE> __device__ __forceinline__ int phys(int i) { return SAMPLE ? (i >> 12) * BLK + phi(i & 4095) : phi(i); }
constexpr int TWB_OFF = 139264;
template <bool INV, typename TP> __device__ __forceinline__ void r16_pass_t(LAS f32x2* Xb, int base, int stride, TP twbase, int off, int twstride) {
    asm volatile("" : "+v"(off));
    f32x2 t[16];
#pragma unroll
    for (int r = 1; r < 16; ++r) t[r] = twbase[off + (r - 1) * twstride];
    f32x2 a[16];
#pragma unroll
    for (int k = 0; k < 16; ++k) a[k] = Xb[base + k * stride];
    constexpr int BR4[16] = {0, 8, 4, 12, 2, 10, 6, 14, 1, 9, 5, 13, 3, 11, 7, 15};
    if (INV) {
#pragma unroll
        for (int r = 1; r < 16; ++r) a[BR4[r]] = cmul(a[BR4[r]], (f32x2){t[r].x, -t[r].y}); }
    dft16<INV>(a);
    if (!INV) {
#pragma unroll
        for (int r = 1; r < 16; ++r) a[BR4[r]] = cmul(a[BR4[r]], t[r]); }
#pragma unroll
    for (int k = 0; k < 16; ++k) Xb[base + k * stride] = a[k];
}
template <bool INV> __device__ __forceinline__ void fft_outer(LAS f32x2* Xb, int j, const f32x2* twa, const LAS f32x2* twb) {
    if (!INV) {
        r16_pass_t<false>(Xb, phi(j), 272, twa, j, 256);
        __syncthreads();
        r16_pass_t<false>(Xb, (j >> 4) * 272 + (j & 15), 17, twb, j & 15, 16);
        asm volatile("s_waitcnt lgkmcnt(0)" ::: "memory");
    } else {
        r16_pass_t<true>(Xb, (j >> 4) * 272 + (j & 15), 17, twb, j & 15, 16);
        __syncthreads();
        r16_pass_t<true>(Xb, phi(j), 272, twa, j, 256);
        __syncthreads();
    }
}
template <bool SAMPLE> __device__ __forceinline__ void mid_pass(LAS f32x2* Xb, const LAS f32x2* Z, int j, int hsel, int order) {
    constexpr int N = SAMPLE ? 8192 : 4096, LOGN = SAMPLE ? 13 : 12; constexpr float SCL = 0.5f / (float)N;
    f32x2 a[16];
#pragma unroll
    for (int k = 0; k < 16; ++k) a[k] = Xb[17 * j + k];
    dft16<false>(a);
    const int pb = (SAMPLE ? hsel * 4096 : 0) + 16 * j;
    const unsigned fj = __brev((unsigned)pb) >> (32 - LOGN), M = (N - fj) & (N - 1), tq = M >> (LOGN - 4);
    const unsigned gq = __brev(M & ((N >> 4) - 1)) >> (32 - LOGN);
    const int zqb = (SAMPLE ? (int)(gq >> 12) * BLK : 0) + (int)((gq & 4095) + ((gq & 4095) >> 4));
#pragma unroll
    for (int k = 0; k < 16; ++k) {
        if ((k & 3) == 0) asm volatile("" ::: "memory");
        constexpr int BR4c[16] = {0, 8, 4, 12, 2, 10, 6, 14, 1, 9, 5, 13, 3, 11, 7, 15};
        const int qk = (int)(__brev((tq - (unsigned)BR4c[k]) & 15u) >> 28);
        const f32x2 zp = Z[(SAMPLE ? hsel * BLK : 0) + 17 * j + k], zq = Z[zqb + qk];
        const f32x2 kk = order == 0 ? (f32x2){(zp.x + zq.x) * SCL, (zp.y - zq.y) * SCL} : (f32x2){(zp.y + zq.y) * SCL, (zq.x - zp.x) * SCL};
        a[k] = cmul(a[k], kk);
    }
    dft16<true>(a);
#pragma unroll
    for (int k = 0; k < 16; ++k) Xb[17 * j + k] = a[k];
    asm volatile("s_waitcnt lgkmcnt(0)" ::: "memory");
}
__device__ __forceinline__ void sconv8(const bf16* row, int t0, int L, float w0, float w1, float w2, float cb, float (&o)[8]) {
    const u32x4 w = *(const u32x4*)(row + t0);
    float u[10];
    u[0] = t0 > 0 ? bf2f((unsigned)row[t0 - 1]) : 0.f; u[9] = t0 + 8 < L ? bf2f((unsigned)row[t0 + 8]) : 0.f;
    u[1] = bflo(w.x); u[2] = bfhi(w.x); u[3] = bflo(w.y); u[4] = bfhi(w.y); u[5] = bflo(w.z); u[6] = bfhi(w.z); u[7] = bflo(w.w); u[8] = bfhi(w.w);
#pragma unroll
    for (int e = 0; e < 8; ++e) o[e] = cb + w0 * u[e] + w1 * u[e + 1] + w2 * u[e + 2];
}

template <bool SAMPLE> __device__ __forceinline__ void conv_unit(const Args& a, int c, LAS unsigned char* lds, int tid) {
    constexpr int L = SAMPLE ? LS : LP, N = 2 * L, LOGN = SAMPLE ? 13 : 12;
    LAS f32x2* X = (LAS f32x2*)lds; LAS f32x2* Z = (LAS f32x2*)(lds + 2 * BLK * 8);
    const bf16* UT = (const bf16*)(a.ws + WS_UT); bf16* HYT = (bf16*)(a.ws + WS_HYT);
    const int grow0 = SAMPLE ? MP : 0;
    const int hsel = __builtin_amdgcn_readfirstlane(tid >> 8), j = tid & 255;
    const f32x2* twa = (const f32x2*)(a.ws + WS_TWA); const LAS f32x2* twb = (const LAS f32x2*)(lds + TWB_OFF);
    const float* cw = a.in[I_CONVW]; const float* cbv = a.in[I_CONVB];
    LAS f32x2* Xh = X + hsel * BLK;
    const int t0 = SAMPLE ? 8 * tid : 8 * j;
    const int p0 = phi(t0);
    const float rev0 = (float)t0 * (1.f / 8192.f);
    const f32x2 wt0 = (f32x2){__builtin_amdgcn_cosf(rev0), -__builtin_amdgcn_sinf(rev0)};
    const f32x2 w1 = (f32x2){0.99999970586288223f, -0.00076699031874270453f};
    constexpr int NIT = SAMPLE ? 4 : 2;
    u32x4 ra, rb; unsigned ea, eb;
#define LDRAW(U0, U1, CH) do { const bf16* _a = (U0) + (size_t)(CH) * L; const bf16* _b = (U1) + (size_t)(CH) * L; \
        ra = *(const u32x4*)(_a + t0); rb = *(const u32x4*)(_b + t0); \
        ea = (t0 > 0 ? (unsigned)_a[t0 - 1] : 0u) | ((t0 + 8 < L ? (unsigned)_a[t0 + 8] : 0u) << 16); \
        eb = (t0 > 0 ? (unsigned)_b[t0 - 1] : 0u) | ((t0 + 8 < L ? (unsigned)_b[t0 + 8] : 0u) << 16); } while (0)
#define SCONV(W, E, CHX, OUT) do { const float _w0 = cw[CHX], _w1 = cw[1536 + (CHX)], _w2 = cw[3072 + (CHX)], _cb = cbv[CHX]; float _u[10]; \
        _u[0] = bflo(E); _u[9] = bfhi(E); _u[1] = bflo(W.x); _u[2] = bfhi(W.x); _u[3] = bflo(W.y); _u[4] = bfhi(W.y); _u[5] = bflo(W.z); _u[6] = bfhi(W.z); _u[7] = bflo(W.w); _u[8] = bfhi(W.w); \
        _Pragma("unroll") for (int _e = 0; _e < 8; ++_e) OUT[_e] = _cb + _w0 * _u[_e] + _w1 * _u[_e + 1] + _w2 * _u[_e + 2]; } while (0)
    {
        const int pair = SAMPLE ? 0 : hsel; const int r0 = grow0 + (2 * pair) * L;
        LDRAW(UT + (size_t)r0 * 1536, UT + (size_t)(r0 + L) * 1536, 1024 + c);
    }
    if (SAMPLE || tid < 256) {
        int tv = tid; asm volatile("" : "+v"(tv));
        const unsigned short* T = (const unsigned short*)(a.ws + WS_TAPS) + (SAMPLE ? LP : 0) + 8 * tv;
        const u32x4 q0 = *(const u32x4*)(T + (size_t)c * (LP + LS)), q1 = *(const u32x4*)(T + (size_t)(512 + c) * (LP + LS)),
                    q2 = *(const u32x4*)(T + (size_t)(1024 + c) * (LP + LS)), q3 = *(const u32x4*)(T + (size_t)(1536 + c) * (LP + LS));
        const float bias0 = a.in[I_HBIAS][c], bias1 = a.in[I_HBIAS][512 + c];
#pragma unroll
        for (int e = 0; e < 8; ++e) {
            const int d = 8 * tv + e; const unsigned sh = (e & 1) * 16;
            const float h0 = (float)__builtin_bit_cast(_Float16, (unsigned short)(q0[e >> 1] >> sh)), h1 = (float)__builtin_bit_cast(_Float16, (unsigned short)(q1[e >> 1] >> sh)),
                        h2 = (float)__builtin_bit_cast(_Float16, (unsigned short)(q2[e >> 1] >> sh)), h3 = (float)__builtin_bit_cast(_Float16, (unsigned short)(q3[e >> 1] >> sh));
            if (d == 0) { Z[phys<SAMPLE>(0)] = (f32x2){h0 + h2 + bias0, h1 + h3 + bias1}; Z[phys<SAMPLE>(L)] = (f32x2){0.f, 0.f}; }
            else { Z[phys<SAMPLE>(d)] = (f32x2){h0, h1}; Z[phys<SAMPLE>(N - d)] = (f32x2){h2, h3}; }
        }
    }
    __syncthreads();
    if (SAMPLE) {
#pragma unroll 1
        for (int t = tid; t < L; t += NTHR) { const int p0 = phi(t); const f32x2 u = Z[p0], v = Z[BLK + p0]; const float rev = (float)t * (1.f / 8192.f);
            const f32x2 w = (f32x2){__builtin_amdgcn_cosf(rev), -__builtin_amdgcn_sinf(rev)};
            Z[p0] = u + v; Z[BLK + p0] = cmul(u - v, w); }
        __syncthreads();
        fft4096<false>(Z + hsel * BLK, j, true);
    } else fft4096<false>(Z, j, hsel == 0);

#pragma unroll 1
    for (int it = 0; it < NIT; ++it) {
        const int pair = SAMPLE ? it : 2 * it + hsel;
        const int r0 = grow0 + (2 * pair) * L, r1 = r0 + L;
        const bf16* u0 = UT + (size_t)r0 * 1536; const bf16* u1 = UT + (size_t)r1 * 1536;
#pragma unroll 1
        for (int order = 0; order < 2; ++order) {
            {
                const int ch = order == 0 ? 1024 + c : c;
                float va[8], vb[8];
                SCONV(ra, ea, ch, va); SCONV(rb, eb, ch, vb);
                LDRAW(u0, u1, order == 0 ? c : 512 + c);
                f32x2 w = wt0;
#pragma unroll
                for (int e = 0; e < 8; ++e) {
                    f32x2 x = (f32x2){va[e], vb[e]};
                    if (order == 1) {
                        f32x2 y;
                        if (SAMPLE) { const f32x2 lo = X[p0 + e], up = X[BLK + p0 + e]; y = lo + cmul(up, (f32x2){w.x, -w.y}); }
                        else y = Xh[p0 + e];
                        x = x * y;
                    }
                    if (SAMPLE) { X[p0 + e] = x; X[BLK + p0 + e] = cmul(x, w); w = cmul(w, w1); }
                    else { Xh[p0 + e] = x; Xh[phi(t0 + e + 2048)] = (f32x2){0.f, 0.f}; }
                }
            }
            __syncthreads();
            fft_outer<false>(Xh, j, twa, twb);
            mid_pass<SAMPLE>(Xh, Z, j, hsel, order);
            fft_outer<true>(Xh, j, twa, twb);
        }
        {
            const int ch = 512 + c;
            float va[8], vb[8];
            SCONV(ra, ea, ch, va); SCONV(rb, eb, ch, vb);
            if (it + 1 < NIT) { const int pn = SAMPLE ? it + 1 : 2 * (it + 1) + hsel; const int rn = grow0 + (2 * pn) * L;
                LDRAW(UT + (size_t)rn * 1536, UT + (size_t)(rn + L) * 1536, 1024 + c); }
            f32x2 w = wt0; float oa[8], ob[8];
#pragma unroll
            for (int e = 0; e < 8; ++e) {
                f32x2 y;
                if (SAMPLE) { const f32x2 lo = X[p0 + e], up = X[BLK + p0 + e]; y = lo + cmul(up, (f32x2){w.x, -w.y}); w = cmul(w, w1); }
                else y = Xh[p0 + e];
                oa[e] = va[e] * y.x; ob[e] = vb[e] * y.y;
            }
            *(u32x4*)(HYT + (size_t)r0 * 512 + (size_t)c * L + t0) = (u32x4){pk2(oa[0], oa[1]), pk2(oa[2], oa[3]), pk2(oa[4], oa[5]), pk2(oa[6], oa[7])};
            *(u32x4*)(HYT + (size_t)r1 * 512 + (size_t)c * L + t0) = (u32x4){pk2(ob[0], ob[1]), pk2(ob[2], ob[3]), pk2(ob[4], ob[5]), pk2(ob[6], ob[7])};
        }
        __syncthreads();
    }
#undef LDRAW
#undef SCONV
}

__device__ __forceinline__ void hy_transpose(const Args& a, LAS unsigned char* lds, int lane, int wave) {
    const bf16* HYT = (const bf16*)(a.ws + WS_HYT); bf16* HY = (bf16*)(a.ws + WS_HY);
    LAS unsigned short* tl = (LAS unsigned short*)(lds + wave * 8704);
    const int gw = blockIdx.x * NWAVES + wave, NGW = gridDim.x * NWAVES;
#pragma unroll 1
    for (int it = gw; it < (MT / 64) * 8; it += NGW) {
        const int rt = it >> 3, cb = it & 7, row0 = rt * 64, c0 = cb * 64;
        int L, brow0;
        if (row0 < MP) { L = LP; brow0 = row0 & ~(LP - 1); } else { L = LS; brow0 = MP + ((row0 - MP) & ~(LS - 1)); }
        const bf16* src = HYT + (size_t)brow0 * 512 + (size_t)c0 * L + (row0 - brow0);
#pragma unroll
        for (int i = 0; i < 8; ++i) { const int r = i * 8 + (lane >> 3), ch = lane & 7;
            const u32x4 w = *(const u32x4*)(src + (size_t)r * L + ch * 8);
            LAS unsigned* d = (LAS unsigned*)(tl + r * 66 + ch * 8); d[0] = w.x; d[1] = w.y; d[2] = w.z; d[3] = w.w; }
        asm volatile("s_waitcnt lgkmcnt(0)" ::: "memory");
#pragma unroll
        for (int i = 0; i < 8; ++i) { const int t = i * 8 + (lane >> 3), ch = lane & 7;
            unsigned v[8];
#pragma unroll
            for (int e = 0; e < 8; ++e) v[e] = tl[(ch * 8 + e) * 66 + t];
            *(u32x4*)(HY + (size_t)(row0 + t) * 512 + c0 + ch * 8) = (u32x4){v[0] | (v[1] << 16), v[2] | (v[3] << 16), v[4] | (v[5] << 16), v[6] | (v[7] << 16)}; }
        asm volatile("s_waitcnt lgkmcnt(0)" ::: "memory");
    }
}

#define XB_TMO      128
#define XB_XCNT(j)  (256  + 64 * (j))
#define XB_XSUB(j)  (1280 + 64 * (j))
#define XB_XGEN(j)  (2304 + 64 * (j))
#define XB_TOP      3328
#define XB_TOPGEN   3392
#define XCD_BAR_WORDS 3456
#define XB_SPIN_CAP (1u << 18)

__device__ __forceinline__ unsigned xb_ld(unsigned* p)              { return __hip_atomic_load(p, __ATOMIC_RELAXED, __HIP_MEMORY_SCOPE_AGENT); }
__device__ __forceinline__ unsigned xb_add(unsigned* p, unsigned v) { return __hip_atomic_fetch_add(p, v, __ATOMIC_RELAXED, __HIP_MEMORY_SCOPE_AGENT); }
__device__ __forceinline__ unsigned xb_xcc_id() { return (unsigned)__builtin_amdgcn_s_getreg((3 << 11) | 20) & 0xFu; }
#define XB_SPIN(cond, bar) do { unsigned _sp = 0; while (cond) { __builtin_amdgcn_s_sleep(1); \
    if ((++_sp & 255u) == 0u) { if (xb_ld(&(bar)[XB_TMO])) break; if (_sp > XB_SPIN_CAP) { atomicAdd(&(bar)[XB_TMO], 1u); break; } } } } while (0)

struct XcdBarrier {
    unsigned* bar; unsigned x;
    volatile LAS unsigned* st;
};

__device__ __forceinline__ XcdBarrier xcd_barrier_post(unsigned* bar, volatile LAS unsigned* st) {
    XcdBarrier b; b.bar = bar; b.x = xb_xcc_id(); b.st = st;
    if (threadIdx.x == 0) (void)xb_add(&bar[XB_XCNT(b.x)], 1u);
    return b;
}
__device__ __forceinline__ void xcd_barrier_complete(unsigned* bar, unsigned x, unsigned& nloc, unsigned& nx) {
    const unsigned G = gridDim.x * gridDim.y * gridDim.z;
    unsigned sum, cnt, mine, sp = 0u;
    for (;;) {
        sum = 0u; cnt = 0u; mine = 0u;
#pragma unroll
        for (unsigned j = 0; j < 16; ++j) { const unsigned c = xb_ld(&bar[XB_XCNT(j)]); sum += c; cnt += (c > 0u) ? 1u : 0u; mine = (j == x) ? c : mine; }
        if (sum == G) break;
        __builtin_amdgcn_s_sleep(1);
        if ((++sp & 255u) == 0u) { if (xb_ld(&bar[XB_TMO])) break; if (sp > XB_SPIN_CAP) { atomicAdd(&bar[XB_TMO], 1u); break; } }
    }
    nloc = mine > 0u ? mine : 1u; nx = cnt > 0u ? cnt : 1u;
}

__device__ __forceinline__ void xcd_barrier(const XcdBarrier& b) {
    asm volatile("s_waitcnt vmcnt(0)" ::: "memory");
    __syncthreads();
    if (threadIdx.x == 0) {
        unsigned* bar = b.bar;
        __builtin_amdgcn_s_waitcnt(0);
        unsigned nloc = b.st[0], nx = b.st[1];
        if (nloc == 0u) { xcd_barrier_complete(bar, b.x, nloc, nx); b.st[0] = nloc; b.st[1] = nx; }
        const unsigned old = xb_add(&bar[XB_XSUB(b.x)], 1u);
        const unsigned gen = old / nloc;
        if (old + 1u == (gen + 1u) * nloc) {
            __builtin_amdgcn_fence(__ATOMIC_RELEASE, "agent");
            asm volatile("s_waitcnt vmcnt(0)" ::: "memory");
            const unsigned og = xb_add(&bar[XB_TOP], 1u);
            const unsigned tg = og / nx;
            if (og + 1u == (tg + 1u) * nx) xb_add(&bar[XB_TOPGEN], 1u);
            else XB_SPIN(xb_ld(&bar[XB_TOPGEN]) == tg, bar);
            __builtin_amdgcn_fence(__ATOMIC_ACQUIRE, "agent");
            xb_add(&bar[XB_XGEN(b.x)], 1u);
            asm volatile("s_waitcnt vmcnt(0)" ::: "memory");
        } else {
            XB_SPIN(xb_ld(&bar[XB_XGEN(b.x)]) == gen, bar);
            __builtin_amdgcn_fence(__ATOMIC_ACQUIRE, "agent");
            asm volatile("s_waitcnt vmcnt(0)" ::: "memory");
        }
    }
    __syncthreads();
}

constexpr int N_PHASES = 10;
#ifndef REP_P0
#define REP_P0 1
#endif
#ifndef REP_P2
#define REP_P2 1
#endif
#ifndef REP_CONV
#define REP_CONV 1
#endif
#ifndef REP_ATT
#define REP_ATT 1
#endif
#ifndef REP_P4
#define REP_P4 1
#endif
#ifndef REP_P7
#define REP_P7 1
#endif
#ifndef REP_N1
#define REP_N1 1
#endif
__global__ void __launch_bounds__(NTHR, 2) fwd_kernel(Args args) {
    extern __shared__ __attribute__((aligned(16))) unsigned char lds_raw[];
    LAS unsigned char* lds = (LAS unsigned char*)lds_raw;
    cg::grid_group grid = cg::this_grid();
#define TIDS int tid = threadIdx.x; asm volatile("" : "+v"(tid)); const int lane = tid & 63, wave = __builtin_amdgcn_readfirstlane(tid >> 6); (void)lane; (void)wave
    unsigned char* ws = args.ws;
    const int lo = args.ph_lo, hi = args.ph_hi;
    volatile LAS unsigned* bst = (volatile LAS unsigned*)(lds + LDS_BYTES - 64);
    if (threadIdx.x == 0) { bst[0] = 0u; bst[1] = 0u; }
    __syncthreads();
    const XcdBarrier xbar = xcd_barrier_post((unsigned*)(ws + WS_BAR), bst);
    const float* modall = (const float*)(ws + WS_MOD);
#define IN(k) (lo <= (k) && (k) < hi)
#define SEAM(k) do { if (IN(k) && IN((k) + 1)) xcd_barrier(xbar); } while (0)
    if (lo < 0) grid.sync();

#ifdef NANFILL
    if (IN(0)) {
        const size_t gt = (size_t)blockIdx.x * NTHR + threadIdx.x, GT = (size_t)gridDim.x * NTHR;
        u32x4* p = (u32x4*)(ws + NANFILL_LO); const size_t n = (NANFILL_HI - NANFILL_LO) / 16;
        for (size_t i = gt; i < n; i += GT) p[i] = (u32x4){0x7fc07fc0u, 0x7fc07fc0u, 0x7fc07fc0u, 0x7fc07fc0u};
#ifdef NANFILL_OUT
        u32x4* q = (u32x4*)((unsigned char*)args.out + 4 * MiB); const size_t nq = ((size_t)MT * DM * 4 - 4 * MiB) / 16;
        for (size_t i = gt; i < nq; i += GT) q[i] = (u32x4){0x7fc07fc0u, 0x7fc07fc0u, 0x7fc07fc0u, 0x7fc07fc0u};
#endif
    }
#endif
    if (IN(0)) for (int rep = 0; rep < REP_P0; ++rep) { TIDS; p0_prologue(args, lds, tid, lane, wave); __syncthreads(); }
    SEAM(0);
    if (IN(1)) {
        { int kdim = 256; asm volatile("" : "+s"(kdim));
          pg8::Gemm g{(const bf16*)args.out + (size_t)(LP + LS) * 256, (const bf16*)args.out, 2048, LP + LS, kdim}; pg8::StaticOrder S; S.init(2048, LP + LS, gridDim.x, (int)blockIdx.x);
          EpiTaps E{(unsigned short*)(ws + WS_TAPS)};
          pg8::gemm_phase<EpiTaps, pg8::StaticOrder, true, true>(lds, g, S, E); }
        TIDS;
        norm_rows<false>(args, nullptr, args.in[I_N1G], 0, 1024, ws + WS_H, lane, wave);
    }
    SEAM(1);
    if (IN(2)) {
        pg8::Gemm g{(const bf16*)(ws + WS_H), (const bf16*)(ws + WS_WIN), MT, NPROJ, DM}; pg8::StaticOrder S; S.init(MT, NPROJ, gridDim.x, (int)blockIdx.x);
        EpiProj E{(bf16*)(ws + WS_Q), (bf16*)(ws + WS_K), (bf16*)(ws + WS_VT), (bf16*)(ws + WS_UT), (bf16*)args.out};
#ifdef EPI2_P2
        EpiTwice E2{E};
        pg8::gemm_phase<EpiTwice, pg8::StaticOrder, true, true>(lds, g, S, E2);
#else
        pg8::gemm_phase<EpiProj, pg8::StaticOrder, true, true>(lds, g, S, E);
#endif
        if (REP_P2 == 2) { __syncthreads(); pg8::gemm_phase<EpiProj, pg8::StaticOrder, true, true>(lds, g, S, E); }
    }
    SEAM(2);
    if (IN(3)) {
        TIDS;
        if (tid < 240) { const int r = tid / 16 + 1, pos = tid & 15; const float rev = (float)((r * pos) & 255) * (1.f / 256.f);
            ((LAS f32x2*)(lds + TWB_OFF))[tid] = (f32x2){__builtin_amdgcn_cosf(rev), -__builtin_amdgcn_sinf(rev)}; }
        __syncthreads();
        for (int rep = 0; rep < REP_CONV; ++rep) for (int u = blockIdx.x; u < 1024; u += gridDim.x) { if (u < 512) conv_unit<true>(args, u, lds, tid); else conv_unit<false>(args, u - 512, lds, tid); }
        for (int rep = 0; rep < REP_ATT; ++rep) for (int u = blockIdx.x; u < 768; u += gridDim.x) attn_unit(args, u, lds, tid, lane, wave);
    }
    SEAM(3);
    if (IN(4)) {
        { TIDS; hy_transpose(args, lds, lane, wave); }
        xcd_barrier(xbar);
        pg8::DualOrder S; S.init(MT, DM, gridDim.x, (int)blockIdx.x);
        pg8::Gemm2 g{(const bf16*)(ws + WS_ATT), (const bf16*)(ws + WS_WAO), (const bf16*)(ws + WS_HY), (const bf16*)(ws + WS_WHO), MT, DM, HW};
        EpiMerge E{(bf16*)(ws + WS_H), (const bf16*)args.out};
        pg8::gemm_phase_dual<EpiMerge, pg8::DualOrder, true, true>(lds, g, S, E);
    }
    SEAM(4);
    if (IN(5)) {
        pg8::StaticOrder S; S.init(MT, DM, gridDim.x, (int)blockIdx.x);
        pg8::Gemm g{(const bf16*)(ws + WS_H), (const bf16*)(ws + WS_WOUT), MT, DM, DM};
        EpiGen<2> E{nullptr, nullptr, 0, args.out, nullptr, args.in[I_XP], args.in[I_XS], modall, 2048};
        pg8::gemm_phase<EpiGen<2>, pg8::StaticOrder, true, true>(lds, g, S, E);
    }
    SEAM(5);
#ifndef REP_N6
#define REP_N6 1
#endif
#ifndef EXTRA_SYNC
#define EXTRA_SYNC 0
#endif
    if (IN(6)) { TIDS; for (int rep = 0; rep < REP_N6; ++rep) norm_rows<false, true>(args, args.out, args.in[I_N2G], 3072, 4096, ws + WS_H, lane, wave);
                 for (int rep = 0; rep < EXTRA_SYNC; ++rep) xcd_barrier(xbar); }
    SEAM(6);
    if (IN(7)) {
        pg8::StaticOrder S; S.init(MT, FF, gridDim.x, (int)blockIdx.x);
        pg8::Gemm g{(const bf16*)(ws + WS_H), (const bf16*)(ws + WS_WUP), MT, FF, DM};
        EpiGen<3> E{(bf16*)(ws + WS_UP), nullptr, 0, nullptr, nullptr, nullptr, nullptr, nullptr, 0};
        pg8::gemm_phase<EpiGen<3>, pg8::StaticOrder, true, true>(lds, g, S, E);
        if (REP_P7 == 2) { __syncthreads(); pg8::gemm_phase<EpiGen<3>, pg8::StaticOrder, true, true>(lds, g, S, E); }
    }
    SEAM(7);
    if (IN(8)) {
        pg8::StaticOrder S; S.init(MT, DM, gridDim.x, (int)blockIdx.x);
        pg8::Gemm g{(const bf16*)(ws + WS_UP), (const bf16*)(ws + WS_WDN), MT, DM, FF};
        EpiGen<4> E{nullptr, nullptr, 0, (float*)(ws + WS_H), args.out, nullptr, nullptr, modall, 5120};
        pg8::gemm_phase<EpiGen<4>, pg8::StaticOrder, true, true>(lds, g, S, E);
    }
    SEAM(8);
    if (IN(9)) { TIDS; norm_rows<true, true>(args, (const float*)(ws + WS_H), args.in[I_FING], 6144, 7168, args.out, lane, wave); }
#undef IN
#undef SEAM
}

#ifndef N_LAUNCHES
#define N_LAUNCHES 1
#endif
extern "C" void kernel_launch(void* const* d_in, const int* in_sizes, int n_in, void* d_out, int out_size, void* d_ws, size_t ws_size, hipStream_t stream) {
    static int grid = 0;
    if (grid == 0) {
        if (n_in != 28 || out_size != MT * DM || ws_size < WS_END) { fprintf(stderr, "kernel_launch: unexpected shapes (n_in %d out %d ws %zu)\n", n_in, out_size, ws_size); grid = -1; return; }
        int dev = 0, cus = 0, per_cu = 0;
        hipGetDevice(&dev); hipDeviceGetAttribute(&cus, hipDeviceAttributeMultiprocessorCount, dev);
        if (hipFuncSetAttribute((const void*)fwd_kernel, hipFuncAttributeMaxDynamicSharedMemorySize, LDS_BYTES) != hipSuccess) { fprintf(stderr, "kernel_launch: hipFuncSetAttribute failed\n"); grid = -1; return; }
        if (hipOccupancyMaxActiveBlocksPerMultiprocessor(&per_cu, (const void*)fwd_kernel, NTHR, LDS_BYTES) != hipSuccess || per_cu < 1) { fprintf(stderr, "kernel_launch: occupancy query says %d\n", per_cu); per_cu = 1; }
        (void)hipGetLastError();
        grid = cus;
    }
    if (grid < 0) return;
    if (hipMemsetAsync((char*)d_ws + WS_BAR, 0, 16384, stream) != hipSuccess) { fprintf(stderr, "kernel_launch: hipMemsetAsync failed\n"); return; }
    Args a{};
    for (int i = 0; i < 28; ++i) a.in[i] = (const float*)d_in[i];
    a.out = (float*)d_out; a.ws = (unsigned char*)d_ws;
    for (int li = 0; li < N_LAUNCHES; ++li) {
        a.ph_lo = (N_LAUNCHES == 1) ? 0 : li; a.ph_hi = (N_LAUNCHES == 1) ? N_PHASES : li + 1;
        void* kargs[] = {&a};
        hipError_t e = hipLaunchCooperativeKernel((const void*)fwd_kernel, dim3(grid), dim3(NTHR), kargs, LDS_BYTES, stream);
        if (e != hipSuccess) { fprintf(stderr, "kernel_launch: cooperative launch %d failed: %s (grid %d)\n", li, hipGetErrorString(e), grid); break; }
    }
}
```

```cpp
#include <hip/hip_runtime.h>
#include <hip/hip_cooperative_groups.h>
#include <cstdio>
#include <cstdint>
namespace cg = cooperative_groups;
namespace pg8 {
#define PG8_LAS __attribute__((address_space(3)))
typedef unsigned short bf16_t;
typedef short bf16x8 __attribute__((ext_vector_type(8)));
typedef float f32x4 __attribute__((ext_vector_type(4)));
typedef unsigned u32x4 __attribute__((ext_vector_type(4)));
constexpr int BM = 256, BK = 64, HALF = 128, HTB = HALF * BK * 2  , STAGE_BYTES = 8 * HTB, NXCD = 8, WGM = 4;

__host__ __device__ __forceinline__ int lds_byte(int r, int c) { const int st = (r >> 4) * 2 + (c >> 5), rr = r & 15, cc = c & 31, ob = rr * 64 + cc * 2; return st * 1024 + (ob ^ (((ob >> 9) & 1) << 5)); }
__host__ __device__ __forceinline__ void stage_rc(int b, int& R, int& C) { const int st = b / 1024, sb = b % 1024, swz = sb ^ (((sb >> 9) & 1) << 5); R = (st >> 1) * 16 + swz / 64; C = (st & 1) * 32 + (swz % 64) / 2; }
__host__ __device__ __forceinline__ int perm32(int rho) { const int n = rho >> 4, i = rho & 15; return 8 * (i >> 2) + 4 * n + (i & 3); }

struct Unit { int pm, pn, sel; };
struct Gemm { const bf16_t* A; const bf16_t* Bt; int M, N, K; };

struct StaticOrder {
    int nM, nN, nwg, G, c;
    __host__ __device__ void init(int M, int N, int G_, int c_) { nM = M / BM; nN = N / BM; nwg = nM * nN; G = G_; c = c_; }
    __host__ __device__ bool next(int i, Unit& u) const {
        const long L = (long)i * G + c; if (L >= nwg) return false;
        int wgid = (int)L; { const int q = nwg / NXCD, r = nwg % NXCD, xcd = wgid % NXCD, off = wgid / NXCD; wgid = (xcd < r ? xcd * (q + 1) : r * (q + 1) + (xcd - r) * q) + off; }
        const int nig = WGM * nN, gid = wgid / nig, fm = gid * WGM, gsz = (nM - fm) < WGM ? (nM - fm) : WGM;
        u.pm = fm + ((wgid % nig) % gsz); u.pn = (wgid % nig) / gsz; u.sel = 0; return true;
    }
    __device__ __forceinline__ void a_ready(const Unit&) const {}
    __device__ __forceinline__ void done(const Unit&) const {}
};
struct DualOrder {
    StaticOrder base;
    __host__ __device__ void init(int M, int N, int G_, int c_) { base.init(M, N, G_, c_); }
    __host__ __device__ bool next(int i, Unit& u) const { if (!base.next(i >> 1, u)) return false; u.sel = i & 1; return true; }
    __device__ __forceinline__ void a_ready(const Unit&) const {}
    __device__ __forceinline__ void done(const Unit&) const {}
};
__device__ __forceinline__ unsigned cvt_pk_bf16(float lo, float hi) { unsigned r; asm volatile("v_cvt_pk_bf16_f32 %0, %1, %2" : "=v"(r) : "v"(lo), "v"(hi)); return r; }
template <class Epi, class Sched, bool ALIGN_EPI = false, bool SP2 = false>
__device__ __forceinline__ void gemm_phase(PG8_LAS unsigned char* lds, const Gemm g, const Sched& S, const Epi& E) {
    const int tid = threadIdx.x, wid = __builtin_amdgcn_readfirstlane(tid >> 6), lane = tid & 63, wr = wid >> 2, wc = wid & 3, fr = lane & 15, fq = lane >> 4;
    const int K = g.K, nt = K / BK;
    unsigned voffA[2], voffB[2];
#pragma unroll
    for (int i = 0; i < 2; ++i) { int R, C; stage_rc(tid * 16 + i * 8192, R, C); const int Rb = Epi::PERM ? ((R & ~31) + perm32(R & 31)) : R;
        voffA[i] = (unsigned)(R * K + C) * 2u; voffB[i] = (unsigned)(Rb * K + C) * 2u; }
    const size_t kstep = (size_t)(BK * 2);
    const size_t hstep = (size_t)HALF * K * 2;
    const size_t tstep = 2 * hstep;
    const unsigned ldsw = (unsigned)wid * 1024u;
    const int aoff = lds_byte(wr * 64 + fr, fq * 8), boff = lds_byte(wc * 32 + fr, fq * 8);
#define PG8_SA(b, h) (((b) * 2 + (h)) * HTB)
#define PG8_SB(b, h) ((4 + (b) * 2 + (h)) * HTB)
#define PG8_STAGE(bufoff, gbase, voff) do { _Pragma("unroll") for (int _i = 0; _i < 2; ++_i) \
        __builtin_amdgcn_global_load_lds((const unsigned*)((const char*)(gbase) + (voff)[_i]), (PG8_LAS unsigned*)(lds + (bufoff) + ldsw + _i * 8192), 16, 0, 0); } while (0)
#define PG8_LDA(dst, b, h) do { _Pragma("unroll") for (int m = 0; m < 4; ++m) _Pragma("unroll") for (int k = 0; k < 2; ++k) dst[m][k] = *(const PG8_LAS bf16x8*)(lds + PG8_SA(b, h) + aoff + m * 2048 + k * 1024); } while (0)
#define PG8_LDB(dst, b, h) do { _Pragma("unroll") for (int n = 0; n < 2; ++n) _Pragma("unroll") for (int k = 0; k < 2; ++k) dst[n][k] = *(const PG8_LAS bf16x8*)(lds + PG8_SB(b, h) + boff + n * 2048 + k * 1024); } while (0)
#define PG8_MMA(ai, bj, At, Bt) do { __builtin_amdgcn_s_setprio(1); _Pragma("unroll") for (int m = 0; m < 4; ++m) _Pragma("unroll") for (int n = 0; n < 2; ++n) _Pragma("unroll") for (int k = 0; k < 2; ++k) \
        acc[ai][bj][m][n] = __builtin_amdgcn_mfma_f32_16x16x32_bf16(Bt[n][k], At[m][k], acc[ai][bj][m][n], 0, 0, 0); __builtin_amdgcn_s_setprio(0); } while (0)
#define PG8_WAIT_V(n) asm volatile("s_waitcnt vmcnt(" #n ")" ::: "memory")
#define PG8_WAIT_L(n) asm volatile("s_waitcnt lgkmcnt(" #n ")" ::: "memory")
#define PG8_BAR __builtin_amdgcn_s_barrier()
#define PG8_SCHED __builtin_amdgcn_sched_barrier(0)
    Unit cur, nxt; int ui = 0;
    if (!S.next(0, cur)) return;
    f32x4 acc[2][2][4][2];
#pragma unroll
    for (int a = 0; a < 2; ++a)
#pragma unroll
        for (int b = 0; b < 2; ++b)
#pragma unroll
            for (int m = 0; m < 4; ++m)
#pragma unroll
                for (int n = 0; n < 2; ++n) acc[a][b][m][n] = (f32x4){0.f, 0.f, 0.f, 0.f};
    bf16x8 At[4][2], B0[2][2], B1[2][2];
    const char* cA = (const char*)g.A + (size_t)cur.pm * tstep; const char* cB = (const char*)g.Bt + (size_t)cur.pn * tstep;
    S.a_ready(cur);
    if constexpr (SP2) {
        PG8_STAGE(PG8_SB(0, 0), cB, voffB); PG8_STAGE(PG8_SB(0, 1), cB + hstep, voffB); PG8_STAGE(PG8_SA(0, 0), cA, voffA); PG8_STAGE(PG8_SA(0, 1), cA + hstep, voffA);
        if (wr == 1) PG8_BAR;
        PG8_WAIT_V(2); PG8_BAR;
        PG8_STAGE(PG8_SB(1, 0), cB + kstep, voffB); PG8_STAGE(PG8_SA(1, 0), cA + kstep, voffA); PG8_STAGE(PG8_SB(1, 1), cB + hstep + kstep, voffB);
        PG8_WAIT_V(6); PG8_BAR;
    } else {
        PG8_STAGE(PG8_SB(0, 0), cB, voffB); PG8_STAGE(PG8_SA(0, 0), cA, voffA); PG8_STAGE(PG8_SB(0, 1), cB + hstep, voffB); PG8_STAGE(PG8_SA(0, 1), cA + hstep, voffA);
        if (wr == 1) PG8_BAR;
        PG8_WAIT_V(4); PG8_BAR;
        PG8_STAGE(PG8_SB(1, 0), cB + kstep, voffB); PG8_STAGE(PG8_SA(1, 0), cA + kstep, voffA); PG8_STAGE(PG8_SB(1, 1), cB + hstep + kstep, voffB);
        PG8_WAIT_V(6); PG8_BAR;
    }
    for (;;) {
        const bool has_next = S.next(ui + 1, nxt);
        const char* nA = has_next ? (const char*)g.A + (size_t)nxt.pm * tstep : cA; const char* nB = has_next ? (const char*)g.Bt + (size_t)nxt.pn * tstep : cB;
        for (int t = 0; t < nt; t += 2) {
            const bool last = (t == nt - 2);
            const char* a1 = cA + (size_t)(t + 1) * kstep;
            const char* a2 = last ? nA : cA + (size_t)(t + 2) * kstep; const char* b2 = last ? nB : cB + (size_t)(t + 2) * kstep;
            const char* a3 = a2 + kstep; const char* b3 = b2 + kstep;
            if (last && has_next) S.a_ready(nxt);
            if constexpr (SP2) {
            PG8_LDB(B0, 0, 0); PG8_LDB(B1, 0, 1); PG8_SCHED; PG8_LDA(At, 0, 0); PG8_STAGE(PG8_SA(1, 1), a1 + hstep, voffA);
            PG8_WAIT_V(8); PG8_WAIT_L(0); PG8_BAR; PG8_MMA(0, 0, At, B0); PG8_MMA(0, 1, At, B1); PG8_BAR; PG8_SCHED;
            PG8_LDA(At, 0, 1); PG8_STAGE(PG8_SB(0, 0), b2, voffB); PG8_STAGE(PG8_SB(0, 1), b2 + hstep, voffB); PG8_STAGE(PG8_SA(0, 0), a2, voffA);
            PG8_WAIT_V(8); PG8_WAIT_L(0); PG8_BAR; PG8_MMA(1, 0, At, B0); PG8_MMA(1, 1, At, B1); PG8_BAR; PG8_SCHED;
            PG8_LDB(B0, 1, 0); PG8_LDB(B1, 1, 1); PG8_SCHED; PG8_LDA(At, 1, 0); PG8_STAGE(PG8_SA(0, 1), a2 + hstep, voffA);
            PG8_WAIT_V(8); PG8_WAIT_L(0); PG8_BAR; PG8_MMA(0, 0, At, B0); PG8_MMA(0, 1, At, B1); PG8_BAR; PG8_SCHED;
            PG8_LDA(At, 1, 1); PG8_STAGE(PG8_SB(1, 0), b3, voffB); PG8_STAGE(PG8_SB(1, 1), b3 + hstep, voffB); PG8_STAGE(PG8_SA(1, 0), a3, voffA);
            PG8_WAIT_V(8); PG8_WAIT_L(0); PG8_BAR; PG8_MMA(1, 0, At, B0); PG8_MMA(1, 1, At, B1); PG8_BAR; PG8_SCHED;
            } else {
            PG8_LDB(B0, 0, 0); PG8_SCHED; PG8_LDA(At, 0, 0); PG8_STAGE(PG8_SA(1, 1), a1 + hstep, voffA);
            PG8_WAIT_L(8); PG8_BAR; PG8_WAIT_L(0); PG8_MMA(0, 0, At, B0); PG8_BAR; PG8_SCHED;
            PG8_LDB(B1, 0, 1); PG8_STAGE(PG8_SB(0, 0), b2, voffB);
            PG8_BAR; PG8_WAIT_L(0); PG8_MMA(0, 1, At, B1); PG8_BAR;
            PG8_LDA(At, 0, 1); PG8_STAGE(PG8_SA(0, 0), a2, voffA);
            PG8_BAR; PG8_WAIT_L(0); PG8_MMA(1, 0, At, B0); PG8_BAR; PG8_SCHED;
            PG8_STAGE(PG8_SB(0, 1), b2 + hstep, voffB);
            PG8_WAIT_V(6); PG8_BAR; PG8_MMA(1, 1, At, B1); PG8_BAR;
            PG8_LDB(B0, 1, 0); PG8_SCHED; PG8_LDA(At, 1, 0); PG8_STAGE(PG8_SA(0, 1), a2 + hstep, voffA);
            PG8_WAIT_L(8); PG8_BAR; PG8_WAIT_L(0); PG8_MMA(0, 0, At, B0); PG8_BAR; PG8_SCHED;
            PG8_LDB(B1, 1, 1); PG8_STAGE(PG8_SB(1, 0), b3, voffB);
            PG8_BAR; PG8_WAIT_L(0); PG8_MMA(0, 1, At, B1); PG8_BAR;
            PG8_LDA(At, 1, 1); PG8_STAGE(PG8_SA(1, 0), a3, voffA);
            PG8_BAR; PG8_WAIT_L(0); PG8_MMA(1, 0, At, B0); PG8_BAR; PG8_SCHED;
            PG8_STAGE(PG8_SB(1, 1), b3 + hstep, voffB);
            PG8_WAIT_V(6); PG8_BAR; PG8_MMA(1, 1, At, B1); PG8_BAR;
            }
        }
        if constexpr (ALIGN_EPI) { if (wr == 0) PG8_BAR; }
        if constexpr (!Epi::AFTER_DRAIN) { E(acc, cur, wr, wc, fr, fq); S.done(cur); }
        if (!has_next) break;
#pragma unroll
        for (int a = 0; a < 2; ++a)
#pragma unroll
            for (int b = 0; b < 2; ++b)
#pragma unroll
                for (int m = 0; m < 4; ++m)
#pragma unroll
                    for (int n = 0; n < 2; ++n) acc[a][b][m][n] = (f32x4){0.f, 0.f, 0.f, 0.f};
        cur = nxt; cA = nA; cB = nB; ++ui;
        if constexpr (ALIGN_EPI) { if (wr == 1) PG8_BAR; }
    }
    PG8_WAIT_V(0);
    if constexpr (!ALIGN_EPI) { if (wr == 0) PG8_BAR; }
    PG8_BAR;
    if constexpr (Epi::AFTER_DRAIN) { E.fused(acc, cur, wr, wc, fr, fq, lds, wid, lane); S.done(cur); }
#undef PG8_SA
#undef PG8_SB
#undef PG8_STAGE
#undef PG8_LDA
#undef PG8_LDB
#undef PG8_MMA
#undef PG8_WAIT_V
#undef PG8_WAIT_L
#undef PG8_BAR
#undef PG8_SCHED
}
struct Gemm2 { const bf16_t* A; const bf16_t* Bt; const bf16_t* A2; const bf16_t* Bt2; int M, N, K; };
template <class Epi, class Sched, bool ALIGN_EPI = false, bool SP2 = false>
__device__ __forceinline__ void gemm_phase_dual(PG8_LAS unsigned char* lds, const Gemm2 g, const Sched& S, const Epi& E) {
    const int tid = threadIdx.x, wid = __builtin_amdgcn_readfirstlane(tid >> 6), lane = tid & 63, wr = wid >> 2, wc = wid & 3, fr = lane & 15, fq = lane >> 4;
    const int K = g.K, nt = K / BK;
    unsigned voffA[2], voffB[2];
#pragma unroll
    for (int i = 0; i < 2; ++i) { int R, C; stage_rc(tid * 16 + i * 8192, R, C); const int Rb = Epi::PERM ? ((R & ~31) + perm32(R & 31)) : R;
        voffA[i] = (unsigned)(R * K + C) * 2u; voffB[i] = (unsigned)(Rb * K + C) * 2u; }
    const size_t kstep = (size_t)(BK * 2);
    const size_t hstep = (size_t)HALF * K * 2;
    const size_t tstep = 2 * hstep;
    const unsigned ldsw = (unsigned)wid * 1024u;
    const int aoff = lds_byte(wr * 64 + fr, fq * 8), boff = lds_byte(wc * 32 + fr, fq * 8);
#define PG8_SA(b, h) (((b) * 2 + (h)) * HTB)
#define PG8_SB(b, h) ((4 + (b) * 2 + (h)) * HTB)
#define PG8_STAGE(bufoff, gbase, voff) do { _Pragma("unroll") for (int _i = 0; _i < 2; ++_i) \
        __builtin_amdgcn_global_load_lds((const unsigned*)((const char*)(gbase) + (voff)[_i]), (PG8_LAS unsigned*)(lds + (bufoff) + ldsw + _i * 8192), 16, 0, 0); } while (0)
#define PG8_LDA(dst, b, h) do { _Pragma("unroll") for (int m = 0; m < 4; ++m) _Pragma("unroll") for (int k = 0; k < 2; ++k) dst[m][k] = *(const PG8_LAS bf16x8*)(lds + PG8_SA(b, h) + aoff + m * 2048 + k * 1024); } while (0)
#define PG8_LDB(dst, b, h) do { _Pragma("unroll") for (int n = 0; n < 2; ++n) _Pragma("unroll") for (int k = 0; k < 2; ++k) dst[n][k] = *(const PG8_LAS bf16x8*)(lds + PG8_SB(b, h) + boff + n * 2048 + k * 1024); } while (0)
#define PG8_MMA(ai, bj, At, Bt) do { __builtin_amdgcn_s_setprio(1); _Pragma("unroll") for (int m = 0; m < 4; ++m) _Pragma("unroll") for (int n = 0; n < 2; ++n) _Pragma("unroll") for (int k = 0; k < 2; ++k) \
        acc[ai][bj][m][n] = __builtin_amdgcn_mfma_f32_16x16x32_bf16(Bt[n][k], At[m][k], acc[ai][bj][m][n], 0, 0, 0); __builtin_amdgcn_s_setprio(0); } while (0)
#define PG8_WAIT_V(n) asm volatile("s_waitcnt vmcnt(" #n ")" ::: "memory")
#define PG8_WAIT_L(n) asm volatile("s_waitcnt lgkmcnt(" #n ")" ::: "memory")
#define PG8_BAR __builtin_amdgcn_s_barrier()
#define PG8_SCHED __builtin_amdgcn_sched_barrier(0)
    Unit cur, nxt; int ui = 0;
    if (!S.next(0, cur)) return;
    f32x4 acc[2][2][4][2];
#pragma unroll
    for (int a = 0; a < 2; ++a)
#pragma unroll
        for (int b = 0; b < 2; ++b)
#pragma unroll
            for (int m = 0; m < 4; ++m)
#pragma unroll
                for (int n = 0; n < 2; ++n) acc[a][b][m][n] = (f32x4){0.f, 0.f, 0.f, 0.f};
    bf16x8 At[4][2], B0[2][2], B1[2][2];
    const char* cA = (const char*)(cur.sel ? g.A2 : g.A) + (size_t)cur.pm * tstep; const char* cB = (const char*)(cur.sel ? g.Bt2 : g.Bt) + (size_t)cur.pn * tstep;
    S.a_ready(cur);
    if constexpr (SP2) {
        PG8_STAGE(PG8_SB(0, 0), cB, voffB); PG8_STAGE(PG8_SB(0, 1), cB + hstep, voffB); PG8_STAGE(PG8_SA(0, 0), cA, voffA); PG8_STAGE(PG8_SA(0, 1), cA + hstep, voffA);
        if (wr == 1) PG8_BAR;
        PG8_WAIT_V(2); PG8_BAR;
        PG8_STAGE(PG8_SB(1, 0), cB + kstep, voffB); PG8_STAGE(PG8_SA(1, 0), cA + kstep, voffA); PG8_STAGE(PG8_SB(1, 1), cB + hstep + kstep, voffB);
        PG8_WAIT_V(6); PG8_BAR;
    } else {
        PG8_STAGE(PG8_SB(0, 0), cB, voffB); PG8_STAGE(PG8_SA(0, 0), cA, voffA); PG8_STAGE(PG8_SB(0, 1), cB + hstep, voffB); PG8_STAGE(PG8_SA(0, 1), cA + hstep, voffA);
        if (wr == 1) PG8_BAR;
        PG8_WAIT_V(4); PG8_BAR;
        PG8_STAGE(PG8_SB(1, 0), cB + kstep, voffB); PG8_STAGE(PG8_SA(1, 0), cA + kstep, voffA); PG8_STAGE(PG8_SB(1, 1), cB + hstep + kstep, voffB);
        PG8_WAIT_V(6); PG8_BAR;
    }
    for (;;) {
        const bool has_next = S.next(ui + 1, nxt);
        const char* nA = has_next ? (const char*)(nxt.sel ? g.A2 : g.A) + (size_t)nxt.pm * tstep : cA; const char* nB = has_next ? (const char*)(nxt.sel ? g.Bt2 : g.Bt) + (size_t)nxt.pn * tstep : cB;
        for (int t = 0; t < nt; t += 2) {
            const bool last = (t == nt - 2);
            const char* a1 = cA + (size_t)(t + 1) * kstep;
            const char* a2 = last ? nA : cA + (size_t)(t + 2) * kstep; const char* b2 = last ? nB : cB + (size_t)(t + 2) * kstep;
            const char* a3 = a2 + kstep; const char* b3 = b2 + kstep;
            if (last && has_next) S.a_ready(nxt);
            if constexpr (SP2) {
            PG8_LDB(B0, 0, 0); PG8_LDB(B1, 0, 1); PG8_SCHED; PG8_LDA(At, 0, 0); PG8_STAGE(PG8_SA(1, 1), a1 + hstep, voffA);
            PG8_WAIT_V(8); PG8_WAIT_L(0); PG8_BAR; PG8_MMA(0, 0, At, B0); PG8_MMA(0, 1, At, B1); PG8_BAR; PG8_SCHED;
            PG8_LDA(At, 0, 1); PG8_STAGE(PG8_SB(0, 0), b2, voffB); PG8_STAGE(PG8_SB(0, 1), b2 + hstep, voffB); PG8_STAGE(PG8_SA(0, 0), a2, voffA);
            PG8_WAIT_V(8); PG8_WAIT_L(0); PG8_BAR; PG8_MMA(1, 0, At, B0); PG8_MMA(1, 1, At, B1); PG8_BAR; PG8_SCHED;
            PG8_LDB(B0, 1, 0); PG8_LDB(B1, 1, 1); PG8_SCHED; PG8_LDA(At, 1, 0); PG8_STAGE(PG8_SA(0, 1), a2 + hstep, voffA);
            PG8_WAIT_V(8); PG8_WAIT_L(0); PG8_BAR; PG8_MMA(0, 0, At, B0); PG8_MMA(0, 1, At, B1); PG8_BAR; PG8_SCHED;
            PG8_LDA(At, 1, 1); PG8_STAGE(PG8_SB(1, 0), b3, voffB); PG8_STAGE(PG8_SB(1, 1), b3 + hstep, voffB); PG8_STAGE(PG8_SA(1, 0), a3, voffA);
            PG8_WAIT_V(8); PG8_WAIT_L(0); PG8_BAR; PG8_MMA(1, 0, At, B0); PG8_MMA(1, 1, At, B1); PG8_BAR; PG8_SCHED;
            } else {
            PG8_LDB(B0, 0, 0); PG8_SCHED; PG8_LDA(At, 0, 0); PG8_STAGE(PG8_SA(1, 1), a1 + hstep, voffA);
            PG8_WAIT_L(8); PG8_BAR; PG8_WAIT_L(0); PG8_MMA(0, 0, At, B0); PG8_BAR; PG8_SCHED;
            PG8_LDB(B1, 0, 1); PG8_STAGE(PG8_SB(0, 0), b2, voffB);
            PG8_BAR; PG8_WAIT_L(0); PG8_MMA(0, 1, At, B1); PG8_BAR;
            PG8_LDA(At, 0, 1); PG8_STAGE(PG8_SA(0, 0), a2, voffA);
            PG8_BAR; PG8_WAIT_L(0); PG8_MMA(1, 0, At, B0); PG8_BAR; PG8_SCHED;
            PG8_STAGE(PG8_SB(0, 1), b2 + hstep, voffB);
            PG8_WAIT_V(6); PG8_BAR; PG8_MMA(1, 1, At, B1); PG8_BAR;
            PG8_LDB(B0, 1, 0); PG8_SCHED; PG8_LDA(At, 1, 0); PG8_STAGE(PG8_SA(0, 1), a2 + hstep, voffA);
            PG8_WAIT_L(8); PG8_BAR; PG8_WAIT_L(0); PG8_MMA(0, 0, At, B0); PG8_BAR; PG8_SCHED;
            PG8_LDB(B1, 1, 1); PG8_STAGE(PG8_SB(1, 0), b3, voffB);
            PG8_BAR; PG8_WAIT_L(0); PG8_MMA(0, 1, At, B1); PG8_BAR;
            PG8_LDA(At, 1, 1); PG8_STAGE(PG8_SA(1, 0), a3, voffA);
            PG8_BAR; PG8_WAIT_L(0); PG8_MMA(1, 0, At, B0); PG8_BAR; PG8_SCHED;
            PG8_STAGE(PG8_SB(1, 1), b3 + hstep, voffB);
            PG8_WAIT_V(6); PG8_BAR; PG8_MMA(1, 1, At, B1); PG8_BAR;
            }
        }
        if constexpr (ALIGN_EPI) { if (wr == 0) PG8_BAR; }
        if (cur.sel == 0) E.mid(acc, cur, wr, wc, fr, fq); else E(acc, cur, wr, wc, fr, fq);
        if (!has_next) break;
        if (cur.sel == 1)
#pragma unroll
        for (int a = 0; a < 2; ++a)
#pragma unroll
            for (int b = 0; b < 2; ++b)
#pragma unroll
                for (int m = 0; m < 4; ++m)
#pragma unroll
                    for (int n = 0; n < 2; ++n) acc[a][b][m][n] = (f32x4){0.f, 0.f, 0.f, 0.f};
        cur = nxt; cA = nA; cB = nB; ++ui;
        if constexpr (ALIGN_EPI) { if (wr == 1) PG8_BAR; }
    }
    PG8_WAIT_V(0);
    if constexpr (!ALIGN_EPI) { if (wr == 0) PG8_BAR; }
    PG8_BAR;
#undef PG8_SA
#undef PG8_SB
#undef PG8_STAGE
#undef PG8_LDA
#undef PG8_LDB
#undef PG8_MMA
#undef PG8_WAIT_V
#undef PG8_WAIT_L
#undef PG8_BAR
#undef PG8_SCHED
}
}

#define GAS __attribute__((address_space(1)))
#define LAS __attribute__((address_space(3)))
typedef unsigned short bf16;
typedef float f32x4 __attribute__((ext_vector_type(4)));
typedef float f32x2 __attribute__((ext_vector_type(2)));
typedef float f32x16 __attribute__((ext_vector_type(16)));
typedef unsigned u32x4 __attribute__((ext_vector_type(4)));
typedef unsigned u32x2 __attribute__((ext_vector_type(2)));
typedef short bf16x8 __attribute__((ext_vector_type(8)));
typedef short bf16x4 __attribute__((ext_vector_type(4)));

constexpr int DM = 1024, MP = 16384, MS = 32768, MT = MP + MS, LP = 2048, LS = 4096;
constexpr int NPROJ = 4352, FF = 4096, HW = 512, NMOD = 8192;
constexpr int NWAVES = 8, NTHR = 512;
constexpr int LDS_BYTES = 147456;
constexpr float LOG2E = 1.4426950408889634f;
constexpr float QSCALE = 0.125f * LOG2E;
constexpr float INV2PI = 0.15915494309189535f;

constexpr size_t MiB = 1u << 20;
constexpr size_t WS_MOD = 0;
constexpr size_t WS_BAR = MiB / 2;
constexpr size_t WS_HFP = MiB / 2;
constexpr size_t WS_HFS = MiB;
constexpr size_t WS_WIN = 2 * MiB;
constexpr size_t WS_WAO = WS_WIN + 17 * MiB / 2;
constexpr size_t WS_WHO = WS_WAO + MiB;
constexpr size_t WS_WOUT = WS_WHO + MiB;
constexpr size_t WS_WUP = WS_WOUT + 2 * MiB;
constexpr size_t WS_WDN = WS_WUP + 8 * MiB;
constexpr size_t WS_H = WS_WDN + 8 * MiB;
constexpr size_t WS_R = WS_H + 96 * MiB;
constexpr size_t WS_Q = WS_R;
constexpr size_t WS_K = WS_Q + 48 * MiB;
constexpr size_t WS_VT = WS_K + 12 * MiB;
constexpr size_t WS_UT = WS_VT + 12 * MiB;
constexpr size_t WS_ATT = WS_UT + 144 * MiB;
constexpr size_t WS_HY = WS_ATT + 48 * MiB;
constexpr size_t WS_HYT = WS_HY + 48 * MiB;
constexpr size_t WS_TAPS = WS_HYT + 48 * MiB;
constexpr size_t WS_UP = WS_R;
constexpr size_t WS_END = WS_R + 384 * MiB;
static_assert(WS_TAPS + 24 * MiB <= WS_END && WS_END <= 512 * MiB, "ws map");

__device__ __forceinline__ unsigned f2bf(float f) { unsigned u = __builtin_bit_cast(unsigned, f); return (u + 0x7fffu + ((u >> 16) & 1u)) >> 16; }
typedef __bf16 bf16x2_t __attribute__((ext_vector_type(2)));
__device__ __forceinline__ unsigned pk2(float lo, float hi) { const f32x2 v = {lo, hi}; const bf16x2_t b = __builtin_convertvector(v, bf16x2_t); return __builtin_bit_cast(unsigned, b); }
__device__ __forceinline__ float bf2f(unsigned h) { return __builtin_bit_cast(float, h << 16); }
__device__ __forceinline__ float bflo(unsigned w) { return __builtin_bit_cast(float, w << 16); }
__device__ __forceinline__ float bfhi(unsigned w) { return __builtin_bit_cast(float, w & 0xffff0000u); }
__device__ __forceinline__ float sin_rev(float r) { r -= floorf(r); return __builtin_amdgcn_sinf(r); }
__device__ __forceinline__ float cos_rev(float r) { r -= floorf(r); return __builtin_amdgcn_cosf(r); }
__device__ __forceinline__ float wave_sum(float v) {
#pragma unroll
    for (int o = 1; o < 64; o <<= 1) v += __shfl_xor(v, o);
    return v;
}
__device__ __forceinline__ f32x2 cmul(f32x2 a, f32x2 b) { return (f32x2){a.x * b.x - a.y * b.y, a.x * b.y + a.y * b.x}; }

struct Args {
    const float* in[28];
    float* out; unsigned char* ws;
    int ph_lo, ph_hi;
};
enum { I_XP = 0, I_XS, I_CP, I_CS, I_WADA, I_BADA, I_N1G, I_WIN, I_SINK, I_CONVW, I_CONVB, I_FW1, I_FB1, I_FF1, I_FW2, I_FB2, I_FF2, I_FW3,
       I_HBIAS, I_WAO, I_WHO, I_WOUT, I_N2G, I_WUP, I_WDN, I_WADAF, I_BADAF, I_FING };

__device__ __forceinline__ int row_batch(int r) { return r < MP ? (r >> 11) : 8 + ((r - MP) >> 12); }

__device__ __forceinline__ void p0_transpose_item(const float* W, int K, int N, bf16* WT, LAS float* scr, int item, int lane) {
    const int nblk = N / 32, kb = item / nblk, nb = item % nblk, k0 = 64 * kb, n0 = 32 * nb;
#pragma unroll 8
    for (int i = 0; i < 32; ++i) { const int kk = 2 * i + (lane >> 5); scr[kk * 33 + (lane & 31)] = W[(size_t)(k0 + kk) * N + n0 + (lane & 31)]; }
    asm volatile("s_waitcnt lgkmcnt(0)" ::: "memory");
    const int c = lane & 7;
#pragma unroll
    for (int j = 0; j < 4; ++j) { const int n = (lane >> 3) + 8 * j; const LAS float* s = scr + (8 * c) * 33 + n;
        u32x4 o; o.x = pk2(s[0 * 33], s[1 * 33]); o.y = pk2(s[2 * 33], s[3 * 33]); o.z = pk2(s[4 * 33], s[5 * 33]); o.w = pk2(s[6 * 33], s[7 * 33]);
        *(u32x4*)(WT + (size_t)(n0 + n) * K + k0 + 8 * c) = o; }
    asm volatile("s_waitcnt lgkmcnt(0)" ::: "memory");
}

__device__ __forceinline__ void p0_prologue(const Args& a, LAS unsigned char* lds, int tid, int lane, int wave) {
    unsigned char* ws = a.ws;
    {
        LAS float* cact = (LAS float*)lds;
        LAS float* red = (LAS float*)(lds + 65536);
        for (int i = tid; i < 16 * 1024; i += NTHR) { const int g = i >> 10, k = i & 1023; const float c = g < 8 ? a.in[I_CP][g * 1024 + k] : a.in[I_CS][(g - 8) * 1024 + k];
            cact[i] = c / (1.f + __expf(-c)); }
        __syncthreads();
        float* modall = (float*)(ws + WS_MOD);
        for (int item = blockIdx.x; item < NMOD / 32; item += gridDim.x) {
            const int cl = tid & 31, kg = tid >> 5, col = item * 32 + cl;
            const float* W; int ldw, cc; float bias;
            if (col < 6144) { W = a.in[I_WADA]; ldw = 6144; cc = col; bias = a.in[I_BADA][cc]; } else { W = a.in[I_WADAF]; ldw = 2048; cc = col - 6144; bias = a.in[I_BADAF][cc]; }
            float acc[16];
#pragma unroll
            for (int g = 0; g < 16; ++g) acc[g] = 0.f;
#pragma unroll 8
            for (int kk = 0; kk < 64; ++kk) { const int k = kg * 64 + kk; const float w = W[(size_t)k * ldw + cc];
#pragma unroll
                for (int g = 0; g < 16; ++g) acc[g] += cact[g * 1024 + k] * w; }
#pragma unroll
            for (int g = 0; g < 16; ++g) red[(kg * 16 + g) * 32 + cl] = acc[g];
            __syncthreads();
            { const int g = tid >> 5; float s = bias;
#pragma unroll
              for (int k2 = 0; k2 < 16; ++k2) s += red[(k2 * 16 + g) * 32 + cl];
              modall[g * NMOD + col] = s; }
            __syncthreads();
        }
    }
    {
        LAS float* scr = (LAS float*)(lds + wave * 16384);
        const int gw = blockIdx.x * NWAVES + wave, NGW = gridDim.x * NWAVES;
        constexpr int I_1 = (DM / 64) * (NPROJ / 32), I_2 = (HW / 64) * (DM / 32), I_3 = I_2, I_4 = (DM / 64) * (DM / 32), I_5 = (DM / 64) * (FF / 32), I_6 = (FF / 64) * (DM / 32);
        constexpr int NITEMS = I_1 + I_2 + I_3 + I_4 + I_5 + I_6;
        for (int it = gw; it < NITEMS; it += NGW) {
            int r = it;
            if (r < I_1) { p0_transpose_item(a.in[I_WIN], DM, NPROJ, (bf16*)(ws + WS_WIN), scr, r, lane); continue; } r -= I_1;
            if (r < I_2) { p0_transpose_item(a.in[I_WAO], HW, DM, (bf16*)(ws + WS_WAO), scr, r, lane); continue; } r -= I_2;
            if (r < I_3) { p0_transpose_item(a.in[I_WHO], HW, DM, (bf16*)(ws + WS_WHO), scr, r, lane); continue; } r -= I_3;
            if (r < I_4) { p0_transpose_item(a.in[I_WOUT], DM, DM, (bf16*)(ws + WS_WOUT), scr, r, lane); continue; } r -= I_4;
            if (r < I_5) { p0_transpose_item(a.in[I_WUP], DM, FF, (bf16*)(ws + WS_WUP), scr, r, lane); continue; } r -= I_5;
            p0_transpose_item(a.in[I_WDN], FF, DM, (bf16*)(ws + WS_WDN), scr, r, lane);
        }
        const float* w1 = a.in[I_FW1]; const float* w2 = a.in[I_FW2];
        const float b1 = a.in[I_FB1][lane], f1 = a.in[I_FF1][lane], b2 = a.in[I_FB2][lane], f2 = a.in[I_FF2][lane];
        for (int pidx = gw; pidx < LP + LS; pidx += NGW) {
            const int L = pidx < LP ? LP : LS, n = pidx < LP ? pidx : pidx - LP;
            float zval = 0.f;
            if (lane == 0) zval = (float)n / (float)(L - 1);
            else if (lane <= 32) { const int i = (lane - 1) & 15; const float fr = 1e-4f + (float)i * ((15.f - 1e-4f) / 15.f);
                const float rev = fr * ((float)n / (float)L);
                zval = lane <= 16 ? cos_rev(rev) : -sin_rev(rev); }
            float pre = b1;
            for (int i = 0; i < 33; ++i) pre += __shfl(zval, i) * w1[i * 64 + lane];
            const float h1 = sin_rev(f1 * pre * INV2PI);
            pre = b2;
            for (int i = 0; i < 64; ++i) pre += __shfl(h1, i) * w2[i * 64 + lane];
            const float h2 = sin_rev(f2 * pre * INV2PI);
            bf16* hb = (bf16*)a.out + (size_t)pidx * 256;
            hb[lane] = (bf16)f2bf(h2); hb[lane + 64] = 0; hb[lane + 128] = 0; hb[lane + 192] = 0;
        }
        {
            bf16* w3t = (bf16*)a.out + (size_t)(LP + LS) * 256;
            for (int idx = blockIdx.x * NTHR + tid; idx < 2048 * 256; idx += gridDim.x * NTHR) { const int col = idx >> 8, jj = idx & 255;
                w3t[idx] = jj < 64 ? (bf16)f2bf(a.in[I_FW3][(size_t)jj * 2048 + col]) : (bf16)0; }
        }
    }
}

template <bool OUTF32, bool SRCBF = false>
__device__ __forceinline__ void norm_rows(const Args& a, const float* src0  , const float* g, int off_sh, int off_sc, void* dst, int lane, int wave) {
    const float* modall = (const float*)(a.ws + WS_MOD);
    const int gw = blockIdx.x * NWAVES + wave, NGW = gridDim.x * NWAVES;
    constexpr int NR = 4;
    f32x4 gg[4];
#pragma unroll
    for (int j = 0; j < 4; ++j) gg[j] = ((const f32x4*)g)[lane + 64 * j];
#pragma unroll 1
    for (int gi = gw; gi < MT / NR; gi += NGW) {
        const int m0 = gi * NR;
        f32x4 v[NR][4]; float ss[NR];
#pragma unroll
        for (int r = 0; r < NR; ++r) { const int m = m0 + r;
            if (SRCBF) {
#pragma unroll
                for (int j = 0; j < 4; ++j) { const u32x2 q = ((const u32x2*)((const bf16*)src0 + (size_t)m * DM))[lane + 64 * j]; v[r][j] = (f32x4){bflo(q.x), bfhi(q.x), bflo(q.y), bfhi(q.y)}; }
            } else {
                const float* x = src0 ? src0 + (size_t)m * DM : (m < MP ? a.in[I_XP] + (size_t)m * DM : a.in[I_XS] + (size_t)(m - MP) * DM);
#pragma unroll
                for (int j = 0; j < 4; ++j) v[r][j] = ((const f32x4*)x)[lane + 64 * j];
            } }
        const int b = row_batch(m0); const float* sh = modall + b * NMOD + off_sh; const float* sc = modall + b * NMOD + off_sc;
        f32x4 scv[4], shv[4];
#pragma unroll
        for (int j = 0; j < 4; ++j) { scv[j] = ((const f32x4*)sc)[lane + 64 * j]; shv[j] = ((const f32x4*)sh)[lane + 64 * j]; }
#pragma unroll
        for (int r = 0; r < NR; ++r) { float s = 0.f;
#pragma unroll
            for (int j = 0; j < 4; ++j) s += (v[r][j].x * v[r][j].x + v[r][j].y * v[r][j].y) + (v[r][j].z * v[r][j].z + v[r][j].w * v[r][j].w);
            ss[r] = 1.f / sqrtf(wave_sum(s) * (1.f / DM) + 1e-6f); }
#pragma unroll
        for (int r = 0; r < NR; ++r) { const int m = m0 + r;
#pragma unroll
            for (int j = 0; j < 4; ++j) {
                const f32x4 o = v[r][j] * ss[r] * gg[j] * (scv[j] + 1.f) + shv[j];
                if (OUTF32) ((f32x4*)dst)[(size_t)m * 256 + lane + 64 * j] = o;
                else ((u32x2*)dst)[(size_t)m * 256 + lane + 64 * j] = (u32x2){pk2(o.x, o.y), pk2(o.z, o.w)};
            } }
    }
}

__device__ __forceinline__ void quad_transpose(float (&v)[4], int lane) {
    const bool hi2 = lane & 2, odd = lane & 1;
    { const float s0 = hi2 ? v[0] : v[2], s1 = hi2 ? v[1] : v[3];
      const float r0 = __builtin_bit_cast(float, __builtin_amdgcn_update_dpp(0, __builtin_bit_cast(int, s0), 0x4E, 0xF, 0xF, false));
      const float r1 = __builtin_bit_cast(float, __builtin_amdgcn_update_dpp(0, __builtin_bit_cast(int, s1), 0x4E, 0xF, 0xF, false));
      if (hi2) { v[0] = r0; v[1] = r1; } else { v[2] = r0; v[3] = r1; } }
    { const float s0 = odd ? v[0] : v[1], s1 = odd ? v[2] : v[3];
      const float r0 = __builtin_bit_cast(float, __builtin_amdgcn_update_dpp(0, __builtin_bit_cast(int, s0), 0xB1, 0xF, 0xF, false));
      const float r1 = __builtin_bit_cast(float, __builtin_amdgcn_update_dpp(0, __builtin_bit_cast(int, s1), 0xB1, 0xF, 0xF, false));
      if (odd) { v[0] = r0; v[2] = r1; } else { v[1] = r0; v[3] = r1; } }
}
__device__ __forceinline__ void store_tr8(bf16* base  , int L, int pos, const f32x4& a0, const f32x4& a1, int lane) {
    float v0[4] = {a0[0], a0[1], a0[2], a0[3]}, v1[4] = {a1[0], a1[1], a1[2], a1[3]};
    quad_transpose(v0, lane); quad_transpose(v1, lane);
    const int q = lane & 3, p4 = pos & ~3;
    *(u32x2*)(base + (size_t)q * L + p4) = (u32x2){pk2(v0[0], v0[1]), pk2(v0[2], v0[3])};
    *(u32x2*)(base + (size_t)(4 + q) * L + p4) = (u32x2){pk2(v1[0], v1[1]), pk2(v1[2], v1[3])};
}
struct EpiProj {
    static constexpr bool PERM = true, AFTER_DRAIN = false;
    bf16 *Q, *Kb, *VT, *UT, *G;
    __device__ __forceinline__ void operator()(const f32x4 (&acc)[2][2][4][2], const pg8::Unit& u, int wr, int wc, int fr, int fq) const {
        const int trow = u.pm * 256, pn = u.pn;
        int L, brow0;
        if (trow < MP) { L = LP; brow0 = trow & ~(LP - 1); } else { L = LS; brow0 = MP + ((trow - MP) & ~(LS - 1)); }
        const int rbase = trow + wr * 64 + fr;
        const int cw = wc * 32 + 8 * fq;
        if (pn <= 2) {
#pragma unroll
            for (int bj = 0; bj < 2; ++bj) {
                if (pn == 2 && bj == 1) {
                    bf16* vt = VT + (size_t)brow0 * 128;
#pragma unroll
                    for (int ai = 0; ai < 2; ++ai)
#pragma unroll
                        for (int m = 0; m < 4; ++m) { const int pos = rbase + ai * 128 + m * 16 - brow0;
                            store_tr8(vt + (size_t)cw * L, L, pos, acc[ai][bj][m][0], acc[ai][bj][m][1], fr); }
                } else {
                    const bool isq = pn < 2;
                    const bool roped = ((wc & 1) == 0) && (fq < 2);
                    const float scl = isq ? QSCALE : 1.f;
#pragma unroll
                    for (int ai = 0; ai < 2; ++ai)
#pragma unroll
                        for (int m = 0; m < 4; ++m) { const int row = rbase + ai * 128 + m * 16; const float pos = (float)(row - brow0);
                            float v[8];
#pragma unroll
                            for (int n = 0; n < 2; ++n)
#pragma unroll
                                for (int r = 0; r < 4; ++r) v[4 * n + r] = acc[ai][bj][m][n][r];
                            if ((wc & 1) == 0) {
#pragma unroll
                                for (int i = 0; i < 8; ++i) {
                                    const float other = __shfl_xor(v[i], 16);
                                    constexpr float IF[8] = {1.0f, 0.19393820f, 0.037612028f, 0.0072944090f, 0.0014146648f, 0.00027435756f, 0.000053208356f, 0.000010319133f};
                                    const float ang = pos * IF[i]; const float rev = ang * INV2PI;
                                    const float cs = cos_rev(rev), sn = sin_rev(rev);
                                    const float rot = fq == 0 ? v[i] * cs - other * sn : v[i] * cs + other * sn;
                                    v[i] = roped ? rot : v[i];
                                }
                            }
                            u32x4 w; w.x = pk2(v[0] * scl, v[1] * scl); w.y = pk2(v[2] * scl, v[3] * scl); w.z = pk2(v[4] * scl, v[5] * scl); w.w = pk2(v[6] * scl, v[7] * scl);
                            if (isq) *(u32x4*)(Q + (size_t)row * 512 + pn * 256 + bj * 128 + cw) = w;
                            else *(u32x4*)(Kb + (size_t)row * 128 + cw) = w; }
                }
            }
        } else if (pn < 9) {
            bf16* ut = UT + (size_t)brow0 * 1536;
            const int ch0 = (pn - 3) * 256 + cw;
#pragma unroll
            for (int bj = 0; bj < 2; ++bj)
#pragma unroll
                for (int ai = 0; ai < 2; ++ai)
#pragma unroll
                    for (int m = 0; m < 4; ++m) { const int pos = rbase + ai * 128 + m * 16 - brow0;
                        store_tr8(ut + (size_t)(ch0 + bj * 128) * L, L, pos, acc[ai][bj][m][0], acc[ai][bj][m][1], fr); }
        } else {
            const int c0 = (pn - 9) * 256 + cw;
#pragma unroll
            for (int ai = 0; ai < 2; ++ai)
#pragma unroll
                for (int m = 0; m < 4; ++m) { const int row = rbase + ai * 128 + m * 16;
#pragma unroll
                    for (int bj = 0; bj < 2; ++bj) { float v[8];
#pragma unroll
                        for (int n = 0; n < 2; ++n)
#pragma unroll
                            for (int r = 0; r < 4; ++r) v[4 * n + r] = __builtin_amdgcn_rcpf(1.f + __builtin_amdgcn_exp2f(-LOG2E * acc[ai][bj][m][n][r]));
                        u32x4 w; w.x = pk2(v[0], v[1]); w.y = pk2(v[2], v[3]); w.z = pk2(v[4], v[5]); w.w = pk2(v[6], v[7]);
                        *(u32x4*)(G + (size_t)row * 2048 + c0 + bj * 128) = w; } }
        }
    }
};

struct EpiTaps {
    static constexpr bool PERM = true, AFTER_DRAIN = false;
    unsigned short* T;
    __device__ __forceinline__ unsigned h2(float a, float b) const { return (unsigned)__builtin_bit_cast(unsigned short, (_Float16)a) | ((unsigned)__builtin_bit_cast(unsigned short, (_Float16)b) << 16); }
    __device__ __forceinline__ void operator()(const f32x4 (&acc)[2][2][4][2], const pg8::Unit& u, int wr, int wc, int fr, int fq) const {
        const float mind = -3.0701134573253944f, maxd = -15.350567286626972f;
        const int pbase = u.pn * 256 + wc * 32 + 8 * fq;
        const int L = pbase < LP ? LP : LS; const float nl = -LOG2E / (float)(L - 1);
        const int nb = pbase < LP ? pbase : pbase - LP;
#pragma unroll
        for (int ai = 0; ai < 2; ++ai)
#pragma unroll
            for (int m = 0; m < 4; ++m) { const int row = u.pm * 256 + ai * 128 + wr * 64 + m * 16 + fr; const int c = row & 511;
                const float dl = fabsf(mind + (float)c * ((maxd - mind) / 511.f)) * nl;
#pragma unroll
                for (int bj = 0; bj < 2; ++bj) { const float t0 = (float)(nb + bj * 128);
                    const f32x4 v0 = acc[ai][bj][m][0], v1 = acc[ai][bj][m][1];
                    u32x4 w;
                    w.x = h2(v0[0] * (__builtin_amdgcn_exp2f(t0 * dl) + 0.05f), v0[1] * (__builtin_amdgcn_exp2f((t0 + 1.f) * dl) + 0.05f));
                    w.y = h2(v0[2] * (__builtin_amdgcn_exp2f((t0 + 2.f) * dl) + 0.05f), v0[3] * (__builtin_amdgcn_exp2f((t0 + 3.f) * dl) + 0.05f));
                    w.z = h2(v1[0] * (__builtin_amdgcn_exp2f((t0 + 4.f) * dl) + 0.05f), v1[1] * (__builtin_amdgcn_exp2f((t0 + 5.f) * dl) + 0.05f));
                    w.w = h2(v1[2] * (__builtin_amdgcn_exp2f((t0 + 6.f) * dl) + 0.05f), v1[3] * (__builtin_amdgcn_exp2f((t0 + 7.f) * dl) + 0.05f));
                    *(u32x4*)(T + (size_t)row * (LP + LS) + pbase + bj * 128) = w; } }
    }
};

#ifndef EPI2_LO
#define EPI2_LO 0
#define EPI2_HI 16
#endif
struct EpiTwice { static constexpr bool PERM = true, AFTER_DRAIN = false; EpiProj e;
    __device__ __forceinline__ void operator()(const f32x4 (&acc)[2][2][4][2], const pg8::Unit& u, int wr, int wc, int fr, int fq) const { e(acc, u, wr, wc, fr, fq); asm volatile("" ::: "memory"); if (u.pn >= EPI2_LO && u.pn <= EPI2_HI) e(acc, u, wr, wc, fr, fq); } };

struct EpiMerge {
    static constexpr bool PERM = true, AFTER_DRAIN = false;
    bf16* O; const bf16* gate;
    __device__ __forceinline__ void mid(f32x4 (&acc)[2][2][4][2], const pg8::Unit& u, int wr, int wc, int fr, int fq) const {
        const int rbase = u.pm * 256 + wr * 64 + fr, cbase = u.pn * 256 + wc * 32 + 8 * fq;
#pragma unroll
        for (int ai = 0; ai < 2; ++ai)
#pragma unroll
            for (int m = 0; m < 4; ++m) { const int row = rbase + ai * 128 + m * 16;
#pragma unroll
                for (int bj = 0; bj < 2; ++bj) { const int col = cbase + bj * 128;
                    const u32x4 ga = *(const u32x4*)(gate + (size_t)row * 2048 + col), gh = *(const u32x4*)(gate + (size_t)row * 2048 + 1024 + col);
                    f32x4& v0 = acc[ai][bj][m][0]; f32x4& v1 = acc[ai][bj][m][1];
                    v0[0] *= bflo(ga.x) * __builtin_amdgcn_rcpf(bflo(gh.x)); v0[1] *= bfhi(ga.x) * __builtin_amdgcn_rcpf(bfhi(gh.x));
                    v0[2] *= bflo(ga.y) * __builtin_amdgcn_rcpf(bflo(gh.y)); v0[3] *= bfhi(ga.y) * __builtin_amdgcn_rcpf(bfhi(gh.y));
                    v1[0] *= bflo(ga.z) * __builtin_amdgcn_rcpf(bflo(gh.z)); v1[1] *= bfhi(ga.z) * __builtin_amdgcn_rcpf(bfhi(gh.z));
                    v1[2] *= bflo(ga.w) * __builtin_amdgcn_rcpf(bflo(gh.w)); v1[3] *= bfhi(ga.w) * __builtin_amdgcn_rcpf(bfhi(gh.w)); } }
    }
    __device__ __forceinline__ void operator()(const f32x4 (&acc)[2][2][4][2], const pg8::Unit& u, int wr, int wc, int fr, int fq) const {
        const int rbase = u.pm * 256 + wr * 64 + fr, cbase = u.pn * 256 + wc * 32 + 8 * fq;
#pragma unroll
        for (int ai = 0; ai < 2; ++ai) {
            u32x4 ghv[4][2];
#pragma unroll
            for (int m = 0; m < 4; ++m)
#pragma unroll
                for (int bj = 0; bj < 2; ++bj) ghv[m][bj] = *(const u32x4*)(gate + (size_t)(rbase + ai * 128 + m * 16) * 2048 + 1024 + cbase + bj * 128);
#pragma unroll
            for (int m = 0; m < 4; ++m) { const int row = rbase + ai * 128 + m * 16;
#pragma unroll
                for (int bj = 0; bj < 2; ++bj) { const int col = cbase + bj * 128;
                    const u32x4 gh = ghv[m][bj];
                    const f32x4 v0 = acc[ai][bj][m][0], v1 = acc[ai][bj][m][1];
                    u32x4 w; w.x = pk2(v0[0] * bflo(gh.x), v0[1] * bfhi(gh.x)); w.y = pk2(v0[2] * bflo(gh.y), v0[3] * bfhi(gh.y));
                    w.z = pk2(v1[0] * bflo(gh.z), v1[1] * bfhi(gh.z)); w.w = pk2(v1[2] * bflo(gh.w), v1[3] * bfhi(gh.w));
                    *(u32x4*)(O + (size_t)row * 1024 + col) = w; } } }
    }
};

template <int MODE> struct EpiGen {
    static constexpr bool PERM = true, AFTER_DRAIN = false;
    bf16* O; const bf16* gate; int goff; float* OUT; const float* R; const float* xp; const float* xs; const float* modall; int moff;
    __device__ __forceinline__ void operator()(const f32x4 (&acc)[2][2][4][2], const pg8::Unit& u, int wr, int wc, int fr, int fq) const {
        const int trow = u.pm * 256;
        const int rbase = trow + wr * 64 + fr;
        const int cbase = u.pn * 256 + wc * 32 + 8 * fq;
        const int b = row_batch(trow);
        if (MODE == 2 || MODE == 4) {
            f32x4 gm[2][2];
#pragma unroll
            for (int bj = 0; bj < 2; ++bj) { const int col = cbase + bj * 128; gm[bj][0] = *(const f32x4*)(modall + b * NMOD + moff + col); gm[bj][1] = *(const f32x4*)(modall + b * NMOD + moff + col + 4); }
#pragma unroll
            for (int ai = 0; ai < 2; ++ai) {
                f32x4 r0[4][2], r1[4][2];
#pragma unroll
                for (int m = 0; m < 4; ++m)
#pragma unroll
                    for (int bj = 0; bj < 2; ++bj) { const int row = rbase + ai * 128 + m * 16, col = cbase + bj * 128;
                        if (MODE == 4) { const u32x4 xb = *(const u32x4*)((const bf16*)R + (size_t)row * DM + col);
                            r0[m][bj] = (f32x4){bflo(xb.x), bfhi(xb.x), bflo(xb.y), bfhi(xb.y)}; r1[m][bj] = (f32x4){bflo(xb.z), bfhi(xb.z), bflo(xb.w), bfhi(xb.w)}; }
                        else if (trow < MP) { const float* rr = xp + (size_t)row * DM + col; r0[m][bj] = ((const f32x4*)rr)[0]; r1[m][bj] = ((const f32x4*)rr)[1]; }
                        else { const float* rr = xs + (size_t)(row - MP) * DM + col; r0[m][bj] = ((const f32x4*)rr)[0]; r1[m][bj] = ((const f32x4*)rr)[1]; } }
#pragma unroll
                for (int m = 0; m < 4; ++m)
#pragma unroll
                    for (int bj = 0; bj < 2; ++bj) { const int row = rbase + ai * 128 + m * 16, col = cbase + bj * 128;
                        const f32x4 o0 = r0[m][bj] + gm[bj][0] * acc[ai][bj][m][0], o1 = r1[m][bj] + gm[bj][1] * acc[ai][bj][m][1];
                        *(u32x4*)((bf16*)OUT + (size_t)row * DM + col) = (u32x4){pk2(o0[0], o0[1]), pk2(o0[2], o0[3]), pk2(o1[0], o1[1]), pk2(o1[2], o1[3])}; }
            }
            return;
        }
#pragma unroll
        for (int ai = 0; ai < 2; ++ai)
#pragma unroll
            for (int m = 0; m < 4; ++m) { const int row = rbase + ai * 128 + m * 16;
#pragma unroll
                for (int bj = 0; bj < 2; ++bj) { const int col = cbase + bj * 128;
                    const f32x4 v0 = acc[ai][bj][m][0], v1 = acc[ai][bj][m][1];
                    if (MODE == 0 || MODE == 1) {
                        const u32x4 gw = *(const u32x4*)(gate + (size_t)row * 2048 + goff + col);
                        float o[8] = {v0[0] * bflo(gw.x), v0[1] * bfhi(gw.x), v0[2] * bflo(gw.y), v0[3] * bfhi(gw.y), v1[0] * bflo(gw.z), v1[1] * bfhi(gw.z), v1[2] * bflo(gw.w), v1[3] * bfhi(gw.w)};
                        u32x4* dst = (u32x4*)(O + (size_t)row * 1024 + col);
                        if (MODE == 1) { const u32x4 t = *dst; o[0] += bflo(t.x); o[1] += bfhi(t.x); o[2] += bflo(t.y); o[3] += bfhi(t.y); o[4] += bflo(t.z); o[5] += bfhi(t.z); o[6] += bflo(t.w); o[7] += bfhi(t.w); }
                        u32x4 w; w.x = pk2(o[0], o[1]); w.y = pk2(o[2], o[3]); w.z = pk2(o[4], o[5]); w.w = pk2(o[6], o[7]);
                        *dst = w;
                    } else if (MODE == 2 || MODE == 4) {
                        f32x4 r0, r1;
                        if (MODE == 4) { const u32x4 xb = *(const u32x4*)((const bf16*)R + (size_t)row * DM + col);
                            r0 = (f32x4){bflo(xb.x), bfhi(xb.x), bflo(xb.y), bfhi(xb.y)}; r1 = (f32x4){bflo(xb.z), bfhi(xb.z), bflo(xb.w), bfhi(xb.w)}; }
                        else if (trow < MP) { const float* rr = xp + (size_t)row * DM + col; r0 = ((const f32x4*)rr)[0]; r1 = ((const f32x4*)rr)[1]; }
                        else { const float* rr = xs + (size_t)(row - MP) * DM + col; r0 = ((const f32x4*)rr)[0]; r1 = ((const f32x4*)rr)[1]; }
                        const f32x4 g0 = *(const f32x4*)(modall + b * NMOD + moff + col), g1 = *(const f32x4*)(modall + b * NMOD + moff + col + 4);
                        const f32x4 o0 = r0 + g0 * v0, o1 = r1 + g1 * v1;
                        *(u32x4*)((bf16*)OUT + (size_t)row * DM + col) = (u32x4){pk2(o0[0], o0[1]), pk2(o0[2], o0[3]), pk2(o1[0], o1[1]), pk2(o1[2], o1[3])};
                    } else {
                        float o[8];
#pragma unroll
                        for (int r = 0; r < 4; ++r) { const float a0 = fmaxf(v0[r], 0.f), a1 = fmaxf(v1[r], 0.f); o[r] = a0 * a0; o[4 + r] = a1 * a1; }
                        u32x4 w; w.x = pk2(o[0], o[1]); w.y = pk2(o[2], o[3]); w.z = pk2(o[4], o[5]); w.w = pk2(o[6], o[7]);
                        __builtin_nontemporal_store(w, (u32x4*)(O + (size_t)row * FF + col));
                    } } }
    }
};

constexpr int AT_KS = 0, AT_KROW = 144, AT_VS = 384 * AT_KROW, AT_VROW = 776;
__device__ __forceinline__ void attn_unit(const Args& a, int unit, LAS unsigned char* lds, int tid, int lane, int wave) {
    const bf16* Q = (const bf16*)(a.ws + WS_Q); const bf16* Kb = (const bf16*)(a.ws + WS_K); const bf16* VT = (const bf16*)(a.ws + WS_VT); bf16* ATT = (bf16*)(a.ws + WS_ATT);
    int L, brow0, qb, kvh;
    if (unit < 256) { L = LP; const int b = unit >> 5, rem = unit & 31; qb = rem >> 1; kvh = rem & 1; brow0 = b * LP; }
    else { const int u2 = unit - 256; L = LS; const int b = u2 >> 6, rem = u2 & 63; qb = rem >> 1; kvh = rem & 1; brow0 = MP + b * LS; }
    const int nqb = L >> 7;
    bf16x8 qfa[2][4];
    {
        const int c_ = lane & 31, hi_ = lane >> 5;
#pragma unroll
        for (int s = 0; s < 2; ++s) { const int task = wave * 2 + s, g = task >> 2, qt = task & 3, head = kvh * 4 + g;
            const bf16* qrow = Q + (size_t)(brow0 + qb * 128 + qt * 32 + c_) * 512 + head * 64 + hi_ * 8;
#pragma unroll
            for (int ks = 0; ks < 4; ++ks) qfa[s][ks] = *(const bf16x8*)(qrow + ks * 16); }
    }
    {
        int tv = tid; asm volatile("" : "+v"(tv));
        u32x4 pk[6], pv[6];
#pragma unroll
        for (int i = 0; i < 6; ++i) { const int ch = tv + NTHR * i, kr = ch >> 3, c8 = ch & 7; const int kpos = (qb - 1) * 128 + kr;
            pk[i] = (u32x4){0u, 0u, 0u, 0u};
            if (kpos >= 0 && kpos < L) pk[i] = *(const u32x4*)(Kb + (size_t)(brow0 + kpos) * 128 + kvh * 64 + c8 * 8); }
#pragma unroll
        for (int i = 0; i < 6; ++i) { const int ch = tv + NTHR * i, d = ch / 48, c16 = ch - d * 48; const int kpos0 = (qb - 1) * 128 + c16 * 8;
            pv[i] = (u32x4){0u, 0u, 0u, 0u};
            if (kpos0 >= 0 && kpos0 < L) pv[i] = *(const u32x4*)(VT + (size_t)brow0 * 128 + (size_t)(kvh * 64 + d) * L + kpos0); }
#pragma unroll
        for (int i = 0; i < 6; ++i) { const int ch = tv + NTHR * i, kr = ch >> 3, c8 = ch & 7; *(LAS u32x4*)(lds + AT_KS + kr * AT_KROW + c8 * 16) = pk[i]; }
#pragma unroll
        for (int i = 0; i < 6; ++i) { const int ch = tv + NTHR * i, d = ch / 48, c16 = ch - d * 48;
            LAS u32x2* dst = (LAS u32x2*)(lds + AT_VS + d * AT_VROW + c16 * 16);
            dst[0] = (u32x2){pv[i].x, pv[i].y}; dst[1] = (u32x2){pv[i].z, pv[i].w}; }
    }
    __syncthreads();
    const int c = lane & 31, hi = lane >> 5;
    for (int s = 0; s < 2; ++s) {
        const int task = wave * 2 + s, g = task >> 2, qt = task & 3, head = kvh * 4 + g;
        const int qrel = qt * 32 + c;
        bf16x8 qf[4];
#pragma unroll
        for (int ks = 0; ks < 4; ++ks) qf[ks] = s == 0 ? qfa[0][ks] : qfa[1][ks];
        float m_run = a.in[I_SINK][head] * LOG2E, l_run = hi == 0 ? 1.f : 0.f;
        f32x16 o0 = {}, o1 = {};
        for (int kb = 0; kb < 3; ++kb) {
            if ((qb == 0 && kb == 0) || (qb == nqb - 1 && kb == 2)) continue;
            f32x16 sc[4];
#define TILE_ON(kt) ((4 * kb + (kt)) >= qt && (4 * kb + (kt)) <= qt + 8)
#pragma unroll
            for (int kt = 0; kt < 4; ++kt) { sc[kt] = (f32x16){};
                if (!TILE_ON(kt)) continue;
#pragma unroll
                for (int ks = 0; ks < 4; ++ks) { const bf16x8 kf = *(const LAS bf16x8*)(lds + AT_KS + (kb * 128 + kt * 32 + c) * AT_KROW + ks * 32 + hi * 16);
                    sc[kt] = __builtin_amdgcn_mfma_f32_32x32x16_bf16(kf, qf[ks], sc[kt], 0, 0, 0); } }
            float mx = -1e30f;
#pragma unroll
            for (int kt = 0; kt < 4; ++kt) { if (!TILE_ON(kt)) continue;
#pragma unroll
                for (int i = 0; i < 16; ++i) { const int krel = (kb - 1) * 128 + kt * 32 + 8 * (i >> 2) + 4 * hi + (i & 3);
                    const int d = krel - qrel; const bool ok = (d <= 128) && (d >= -128);
                    sc[kt][i] = ok ? sc[kt][i] : -1e30f; mx = fmaxf(mx, sc[kt][i]); } }
            mx = fmaxf(mx, __shfl_xor(mx, 32));
            const float m_new = fmaxf(m_run, mx), alpha = __builtin_amdgcn_exp2f(m_run - m_new);
            m_run = m_new;
            float ls = 0.f;
#pragma unroll
            for (int kt = 0; kt < 4; ++kt) { if (!TILE_ON(kt)) continue;
#pragma unroll
                for (int i = 0; i < 16; ++i) { const float p = __builtin_amdgcn_exp2f(sc[kt][i] - m_new); sc[kt][i] = p; ls += p; } }
            l_run = l_run * alpha + ls;
            o0 = o0 * alpha; o1 = o1 * alpha;
#pragma unroll
            for (int kt = 0; kt < 4; ++kt) { if (!TILE_ON(kt)) continue;
#pragma unroll
                for (int hA = 0; hA < 2; ++hA) {
                    bf16x8 pb; { const u32x4 w = (u32x4){pk2(sc[kt][8 * hA + 0], sc[kt][8 * hA + 1]), pk2(sc[kt][8 * hA + 2], sc[kt][8 * hA + 3]), pk2(sc[kt][8 * hA + 4], sc[kt][8 * hA + 5]), pk2(sc[kt][8 * hA + 6], sc[kt][8 * hA + 7])};
                        pb = __builtin_bit_cast(bf16x8, w); }
                    const int kidx = kb * 128 + kt * 32 + 16 * hA + 4 * hi;
                    { const LAS u32x2* vp = (const LAS u32x2*)(lds + AT_VS + c * AT_VROW + kidx * 2); const u32x2 x0 = vp[0], x1 = vp[2];
                      const bf16x8 vf = __builtin_bit_cast(bf16x8, (u32x4){x0.x, x0.y, x1.x, x1.y});
                      o0 = __builtin_amdgcn_mfma_f32_32x32x16_bf16(vf, pb, o0, 0, 0, 0); }
                    { const LAS u32x2* vp = (const LAS u32x2*)(lds + AT_VS + (32 + c) * AT_VROW + kidx * 2); const u32x2 x0 = vp[0], x1 = vp[2];
                      const bf16x8 vf = __builtin_bit_cast(bf16x8, (u32x4){x0.x, x0.y, x1.x, x1.y});
                      o1 = __builtin_amdgcn_mfma_f32_32x32x16_bf16(vf, pb, o1, 0, 0, 0); }
                } }
#undef TILE_ON
        }
        const float inv = 1.f / (l_run + __shfl_xor(l_run, 32));
        bf16* orow = ATT + (size_t)(brow0 + qb * 128 + qrel) * 512 + head * 64 + 4 * hi;
#pragma unroll
        for (int ig = 0; ig < 4; ++ig) {
            *(u32x2*)(orow + 8 * ig) = (u32x2){pk2(o0[4 * ig] * inv, o0[4 * ig + 1] * inv), pk2(o0[4 * ig + 2] * inv, o0[4 * ig + 3] * inv)};
            *(u32x2*)(orow + 32 + 8 * ig) = (u32x2){pk2(o1[4 * ig] * inv, o1[4 * ig + 1] * inv), pk2(o1[4 * ig + 2] * inv, o1[4 * ig + 3] * inv)};
        }
    }
    __syncthreads();
}

constexpr int BLK = 4352;
__device__ __forceinline__ int phi(int i) { return i + (i >> 4); }
__device__ __forceinline__ f32x2 mulw16(f32x2 a, int k, bool cj) {
    constexpr float C1 = 0.92387953251128674f, S1 = 0.38268343236508977f, R2 = 0.70710678118654752f;
    k &= 15;
    if (k == 0) return a;
    if (k == 8) return -a;
    if (k == 4) return cj ? (f32x2){-a.y, a.x} : (f32x2){a.y, -a.x};
    if (k == 12) return cj ? (f32x2){a.y, -a.x} : (f32x2){-a.y, a.x};
    float cs, sn;
    switch (k) { case 1: cs = C1; sn = S1; break; case 2: cs = R2; sn = R2; break; case 3: cs = S1; sn = C1; break; case 5: cs = -S1; sn = C1; break;
                 case 6: cs = -R2; sn = R2; break; case 7: cs = -C1; sn = S1; break; case 9: cs = -C1; sn = -S1; break; case 10: cs = -R2; sn = -R2; break;
                 case 11: cs = -S1; sn = -C1; break; case 13: cs = S1; sn = -C1; break; case 14: cs = R2; sn = -R2; break; default: cs = C1; sn = -S1; break; }
    const float wy = cj ? sn : -sn;
    return (f32x2){a.x * cs - a.y * wy, a.x * wy + a.y * cs};
}
template <bool INV> __device__ __forceinline__ void dft16(f32x2 (&a)[16]) {
    if (!INV) {
#pragma unroll
        for (int k = 0; k < 8; ++k) { const f32x2 u = a[k], v = a[k + 8]; a[k] = u + v; a[k + 8] = mulw16(u - v, k, false); }
#pragma unroll
        for (int h = 0; h < 16; h += 8)
#pragma unroll
            for (int k = 0; k < 4; ++k) { const f32x2 u = a[h + k], v = a[h + k + 4]; a[h + k] = u + v; a[h + k + 4] = mulw16(u - v, 2 * k, false); }
#pragma unroll
        for (int h = 0; h < 16; h += 4)
#pragma unroll
            for (int k = 0; k < 2; ++k) { const f32x2 u = a[h + k], v = a[h + k + 2]; a[h + k] = u + v; a[h + k + 2] = mulw16(u - v, 4 * k, false); }
#pragma unroll
        for (int h = 0; h < 16; h += 2) { const f32x2 u = a[h], v = a[h + 1]; a[h] = u + v; a[h + 1] = u - v; }
    } else {
#pragma unroll
        for (int h = 0; h < 16; h += 2) { const f32x2 u = a[h], v = a[h + 1]; a[h] = u + v; a[h + 1] = u - v; }
#pragma unroll
        for (int h = 0; h < 16; h += 4)
#pragma unroll
            for (int k = 0; k < 2; ++k) { const f32x2 u = a[h + k], v = mulw16(a[h + k + 2], 4 * k, true); a[h + k] = u + v; a[h + k + 2] = u - v; }
#pragma unroll
        for (int h = 0; h < 16; h += 8)
#pragma unroll
            for (int k = 0; k < 4; ++k) { const f32x2 u = a[h + k], v = mulw16(a[h + k + 4], 2 * k, true); a[h + k] = u + v; a[h + k + 4] = u - v; }
#pragma unroll
        for (int k = 0; k < 8; ++k) { const f32x2 u = a[k], v = mulw16(a[k + 8], k, true); a[k] = u + v; a[k + 8] = u - v; }
    }
}
template <bool INV, bool TW> __device__ __forceinline__ void r16_pass(LAS f32x2* Xb, int base, int stride, float rev) {
    f32x2 a[16];
#pragma unroll
    for (int k = 0; k < 16; ++k) a[k] = Xb[base + k * stride];
    constexpr int BR4[16] = {0, 8, 4, 12, 2, 10, 6, 14, 1, 9, 5, 13, 3, 11, 7, 15};
    f32x2 t1 = (f32x2){1.f, 0.f};
    if (TW) {
        asm volatile("" : "+v"(rev));
        const float cs = __builtin_amdgcn_cosf(rev), sn = __builtin_amdgcn_sinf(rev);
        t1 = (f32x2){cs, INV ? sn : -sn};
    }
    if (INV && TW) { f32x2 tr = t1;
#pragma unroll
        for (int r = 1; r < 16; ++r) { a[BR4[r]] = cmul(a[BR4[r]], tr); if (r < 15) tr = cmul(tr, t1); } }
    dft16<INV>(a);
    if (!INV && TW) { f32x2 tr = t1;
#pragma unroll
        for (int r = 1; r < 16; ++r) { a[BR4[r]] = cmul(a[BR4[r]], tr); if (r < 15) tr = cmul(tr, t1); } }
#pragma unroll
    for (int k = 0; k < 16; ++k) Xb[base + k * stride] = a[k];
}
template <bool INV> __device__ __forceinline__ void fft4096(LAS f32x2* Xb, int j, bool active) {
    if (!INV) {
        if (active) r16_pass<false, true>(Xb, phi(j), 272, (float)j * (1.f / 4096.f));
        __syncthreads();
        if (active) r16_pass<false, true>(Xb, (j >> 4) * 272 + (j & 15), 17, (float)(j & 15) * (1.f / 256.f));
        __syncthreads();
        if (active) r16_pass<false, false>(Xb, 17 * j, 1, 0.f);
        __syncthreads();
    } else {
        if (active) r16_pass<true, false>(Xb, 17 * j, 1, 0.f);
        __syncthreads();
        if (active) r16_pass<true, true>(Xb, (j >> 4) * 272 + (j & 15), 17, (float)(j & 15) * (1.f / 256.f));
        __syncthreads();
        if (active) r16_pass<true, true>(Xb, phi(j), 272, (float)j * (1.f / 4096.f));
        __syncthreads();
    }
}
template <bool SAMPLE> __device__ __forceinline__ int phys(int i) { return SAMPLE ? (i >> 12) * BLK + phi(i & 4095) : phi(i); }
template <bool INV> __device__ __forceinline__ void fft_outer(LAS f32x2* Xb, int j) {
    if (!INV) {
        r16_pass<false, true>(Xb, phi(j), 272, (float)j * (1.f / 4096.f));
        __syncthreads();
        r16_pass<false, true>(Xb, (j >> 4) * 272 + (j & 15), 17, (float)(j & 15) * (1.f / 256.f));
        asm volatile("s_waitcnt lgkmcnt(0)" ::: "memory");
    } else {
        r16_pass<true, true>(Xb, (j >> 4) * 272 + (j & 15), 17, (float)(j & 15) * (1.f / 256.f));
        __syncthreads();
        r16_pass<true, true>(Xb, phi(j), 272, (float)j * (1.f / 4096.f));
        __syncthreads();
    }
}
template <bool SAMPLE> __device__ __forceinline__ void mid_pass(LAS f32x2* Xb, const LAS f32x2* Z, int j, int hsel, int order) {
    constexpr int N = SAMPLE ? 8192 : 4096, LOGN = SAMPLE ? 13 : 12; constexpr float SCL = 0.5f / (float)N;
    f32x2 a[16];
#pragma unroll
    for (int k = 0; k < 16; ++k) a[k] = Xb[17 * j + k];
    dft16<false>(a);
    const int pb = (SAMPLE ? hsel * 4096 : 0) + 16 * j;
    const unsigned fj = __brev((unsigned)pb) >> (32 - LOGN), M = (N - fj) & (N - 1), tq = M >> (LOGN - 4);
    const unsigned gq = __brev(M & ((N >> 4) - 1)) >> (32 - LOGN);
    const int zqb = (SAMPLE ? (int)(gq >> 12) * BLK : 0) + (int)((gq & 4095) + ((gq & 4095) >> 4));
#pragma unroll
    for (int k = 0; k < 16; ++k) {
        if ((k & 3) == 0) asm volatile("" ::: "memory");
        constexpr int BR4c[16] = {0, 8, 4, 12, 2, 10, 6, 14, 1, 9, 5, 13, 3, 11, 7, 15};
        const int qk = (int)(__brev((tq - (unsigned)BR4c[k]) & 15u) >> 28);
        const f32x2 zp = Z[(SAMPLE ? hsel * BLK : 0) + 17 * j + k], zq = Z[zqb + qk];
        const f32x2 kk = order == 0 ? (f32x2){(zp.x + zq.x) * SCL, (zp.y - zq.y) * SCL} : (f32x2){(zp.y + zq.y) * SCL, (zq.x - zp.x) * SCL};
        a[k] = cmul(a[k], kk);
    }
    dft16<true>(a);
#pragma unroll
    for (int k = 0; k < 16; ++k) Xb[17 * j + k] = a[k];
    asm volatile("s_waitcnt lgkmcnt(0)" ::: "memory");
}
__device__ __forceinline__ void sconv8(const bf16* row, int t0, int L, float w0, float w1, float w2, float cb, float (&o)[8]) {
    const u32x4 w = *(const u32x4*)(row + t0);
    float u[10];
    u[0] = t0 > 0 ? bf2f((unsigned)row[t0 - 1]) : 0.f; u[9] = t0 + 8 < L ? bf2f((unsigned)row[t0 + 8]) : 0.f;
    u[1] = bflo(w.x); u[2] = bfhi(w.x); u[3] = bflo(w.y); u[4] = bfhi(w.y); u[5] = bflo(w.z); u[6] = bfhi(w.z); u[7] = bflo(w.w); u[8] = bfhi(w.w);
#pragma unroll
    for (int e = 0; e < 8; ++e) o[e] = cb + w0 * u[e] + w1 * u[e + 1] + w2 * u[e + 2];
}

template <bool SAMPLE> __device__ __forceinline__ void conv_unit(const Args& a, int c, LAS unsigned char* lds, int tid) {
    constexpr int L = SAMPLE ? LS : LP, N = 2 * L, LOGN = SAMPLE ? 13 : 12;
    LAS f32x2* X = (LAS f32x2*)lds; LAS f32x2* Z = (LAS f32x2*)(lds + 2 * BLK * 8);
    const bf16* UT = (const bf16*)(a.ws + WS_UT); bf16* HYT = (bf16*)(a.ws + WS_HYT);
    const int grow0 = SAMPLE ? MP : 0;
    const int hsel = __builtin_amdgcn_readfirstlane(tid >> 8), j = tid & 255;
    const float* cw = a.in[I_CONVW]; const float* cbv = a.in[I_CONVB];
    LAS f32x2* Xh = X + hsel * BLK;
    const int t0 = SAMPLE ? 8 * tid : 8 * j;
    const int p0 = phi(t0);
    const float rev0 = (float)t0 * (1.f / 8192.f);
    const f32x2 wt0 = (f32x2){__builtin_amdgcn_cosf(rev0), -__builtin_amdgcn_sinf(rev0)};
    const f32x2 w1 = (f32x2){0.99999970586288223f, -0.00076699031874270453f};
    constexpr int NIT = SAMPLE ? 4 : 2;
    u32x4 ra, rb; unsigned ea, eb;
#define LDRAW(U0, U1, CH) do { const bf16* _a = (U0) + (size_t)(CH) * L; const bf16* _b = (U1) + (size_t)(CH) * L; \
        ra = *(const u32x4*)(_a + t0); rb = *(const u32x4*)(_b + t0); \
        ea = (t0 > 0 ? (unsigned)_a[t0 - 1] : 0u) | ((t0 + 8 < L ? (unsigned)_a[t0 + 8] : 0u) << 16); \
        eb = (t0 > 0 ? (unsigned)_b[t0 - 1] : 0u) | ((t0 + 8 < L ? (unsigned)_b[t0 + 8] : 0u) << 16); } while (0)
#define SCONV(W, E, CHX, OUT) do { const float _w0 = cw[CHX], _w1 = cw[1536 + (CHX)], _w2 = cw[3072 + (CHX)], _cb = cbv[CHX]; float _u[10]; \
        _u[0] = bflo(E); _u[9] = bfhi(E); _u[1] = bflo(W.x); _u[2] = bfhi(W.x); _u[3] = bflo(W.y); _u[4] = bfhi(W.y); _u[5] = bflo(W.z); _u[6] = bfhi(W.z); _u[7] = bflo(W.w); _u[8] = bfhi(W.w); \
        _Pragma("unroll") for (int _e = 0; _e < 8; ++_e) OUT[_e] = _cb + _w0 * _u[_e] + _w1 * _u[_e + 1] + _w2 * _u[_e + 2]; } while (0)
    {
        const int pair = SAMPLE ? 0 : hsel; const int r0 = grow0 + (2 * pair) * L;
        LDRAW(UT + (size_t)r0 * 1536, UT + (size_t)(r0 + L) * 1536, 1024 + c);
    }
    if (SAMPLE || tid < 256) {
        int tv = tid; asm volatile("" : "+v"(tv));
        const unsigned short* T = (const unsigned short*)(a.ws + WS_TAPS) + (SAMPLE ? LP : 0) + 8 * tv;
        const u32x4 q0 = *(const u32x4*)(T + (size_t)c * (LP + LS)), q1 = *(const u32x4*)(T + (size_t)(512 + c) * (LP + LS)),
                    q2 = *(const u32x4*)(T + (size_t)(1024 + c) * (LP + LS)), q3 = *(const u32x4*)(T + (size_t)(1536 + c) * (LP + LS));
        const float bias0 = a.in[I_HBIAS][c], bias1 = a.in[I_HBIAS][512 + c];
#pragma unroll
        for (int e = 0; e < 8; ++e) {
            const int d = 8 * tv + e; const unsigned sh = (e & 1) * 16;
            const float h0 = (float)__builtin_bit_cast(_Float16, (unsigned short)(q0[e >> 1] >> sh)), h1 = (float)__builtin_bit_cast(_Float16, (unsigned short)(q1[e >> 1] >> sh)),
                        h2 = (float)__builtin_bit_cast(_Float16, (unsigned short)(q2[e >> 1] >> sh)), h3 = (float)__builtin_bit_cast(_Float16, (unsigned short)(q3[e >> 1] >> sh));
            if (d == 0) { Z[phys<SAMPLE>(0)] = (f32x2){h0 + h2 + bias0, h1 + h3 + bias1}; Z[phys<SAMPLE>(L)] = (f32x2){0.f, 0.f}; }
            else { Z[phys<SAMPLE>(d)] = (f32x2){h0, h1}; Z[phys<SAMPLE>(N - d)] = (f32x2){h2, h3}; }
        }
    }
    __syncthreads();
    if (SAMPLE) {
#pragma unroll 1
        for (int t = tid; t < L; t += NTHR) { const int p0 = phi(t); const f32x2 u = Z[p0], v = Z[BLK + p0]; const float rev = (float)t * (1.f / 8192.f);
            const f32x2 w = (f32x2){__builtin_amdgcn_cosf(rev), -__builtin_amdgcn_sinf(rev)};
            Z[p0] = u + v; Z[BLK + p0] = cmul(u - v, w); }
        __syncthreads();
        fft4096<false>(Z + hsel * BLK, j, true);
    } else fft4096<false>(Z, j, hsel == 0);

#pragma unroll 1
    for (int it = 0; it < NIT; ++it) {
        const int pair = SAMPLE ? it : 2 * it + hsel;
        const int r0 = grow0 + (2 * pair) * L, r1 = r0 + L;
        const bf16* u0 = UT + (size_t)r0 * 1536; const bf16* u1 = UT + (size_t)r1 * 1536;
#pragma unroll 1
        for (int order = 0; order < 2; ++order) {
            {
                const int ch = order == 0 ? 1024 + c : c;
                float va[8], vb[8];
                SCONV(ra, ea, ch, va); SCONV(rb, eb, ch, vb);
                LDRAW(u0, u1, order == 0 ? c : 512 + c);
                f32x2 w = wt0;
#pragma unroll
                for (int e = 0; e < 8; ++e) {
                    f32x2 x = (f32x2){va[e], vb[e]};
                    if (order == 1) {
                        f32x2 y;
                        if (SAMPLE) { const f32x2 lo = X[p0 + e], up = X[BLK + p0 + e]; y = lo + cmul(up, (f32x2){w.x, -w.y}); }
                        else y = Xh[p0 + e];
                        x = x * y;
                    }
                    if (SAMPLE) { X[p0 + e] = x; X[BLK + p0 + e] = cmul(x, w); w = cmul(w, w1); }
                    else { Xh[p0 + e] = x; Xh[phi(t0 + e + 2048)] = (f32x2){0.f, 0.f}; }
                }
            }
            __syncthreads();
            fft_outer<false>(Xh, j);
            mid_pass<SAMPLE>(Xh, Z, j, hsel, order);
            fft_outer<true>(Xh, j);
        }
        {
            const int ch = 512 + c;
            float va[8], vb[8];
            SCONV(ra, ea, ch, va); SCONV(rb, eb, ch, vb);
            if (it + 1 < NIT) { const int pn = SAMPLE ? it + 1 : 2 * (it + 1) + hsel; const int rn = grow0 + (2 * pn) * L;
                LDRAW(UT + (size_t)rn * 1536, UT + (size_t)(rn + L) * 1536, 1024 + c); }
            f32x2 w = wt0; float oa[8], ob[8];
#pragma unroll
            for (int e = 0; e < 8; ++e) {
                f32x2 y;
                if (SAMPLE) { const f32x2 lo = X[p0 + e], up = X[BLK + p0 + e]; y = lo + cmul(up, (f32x2){w.x, -w.y}); w = cmul(w, w1); }
                else y = Xh[p0 + e];
                oa[e] = va[e] * y.x; ob[e] = vb[e] * y.y;
            }
            *(u32x4*)(HYT + (size_t)r0 * 512 + (size_t)c * L + t0) = (u32x4){pk2(oa[0], oa[1]), pk2(oa[2], oa[3]), pk2(oa[4], oa[5]), pk2(oa[6], oa[7])};
            *(u32x4*)(HYT + (size_t)r1 * 512 + (size_t)c * L + t0) = (u32x4){pk2(ob[0], ob[1]), pk2(ob[2], ob[3]), pk2(ob[4], ob[5]), pk2(ob[6], ob[7])};
        }
        __syncthreads();
    }
#undef LDRAW
#undef SCONV
}

__device__ __forceinline__ void hy_transpose(const Args& a, LAS unsigned char* lds, int lane, int wave) {
    const bf16* HYT = (const bf16*)(a.ws + WS_HYT); bf16* HY = (bf16*)(a.ws + WS_HY);
    LAS unsigned short* tl = (LAS unsigned short*)(lds + wave * 8704);
    const int gw = blockIdx.x * NWAVES + wave, NGW = gridDim.x * NWAVES;
#pragma unroll 1
    for (int it = gw; it < (MT / 64) * 8; it += NGW) {
        const int rt = it >> 3, cb = it & 7, row0 = rt * 64, c0 = cb * 64;
        int L, brow0;
        if (row0 < MP) { L = LP; brow0 = row0 & ~(LP - 1); } else { L = LS; brow0 = MP + ((row0 - MP) & ~(LS - 1)); }
        const bf16* src = HYT + (size_t)brow0 * 512 + (size_t)c0 * L + (row0 - brow0);
#pragma unroll
        for (int i = 0; i < 8; ++i) { const int r = i * 8 + (lane >> 3), ch = lane & 7;
            const u32x4 w = *(const u32x4*)(src + (size_t)r * L + ch * 8);
            LAS unsigned* d = (LAS unsigned*)(tl + r * 66 + ch * 8); d[0] = w.x; d[1] = w.y; d[2] = w.z; d[3] = w.w; }
        asm volatile("s_waitcnt lgkmcnt(0)" ::: "memory");
#pragma unroll
        for (int i = 0; i < 8; ++i) { const int t = i * 8 + (lane >> 3), ch = lane & 7;
            unsigned v[8];
#pragma unroll
            for (int e = 0; e < 8; ++e) v[e] = tl[(ch * 8 + e) * 66 + t];
            *(u32x4*)(HY + (size_t)(row0 + t) * 512 + c0 + ch * 8) = (u32x4){v[0] | (v[1] << 16), v[2] | (v[3] << 16), v[4] | (v[5] << 16), v[6] | (v[7] << 16)}; }
        asm volatile("s_waitcnt lgkmcnt(0)" ::: "memory");
    }
}

#define XB_TMO      128
#define XB_XCNT(j)  (256  + 64 * (j))
#define XB_XSUB(j)  (1280 + 64 * (j))
#define XB_XGEN(j)  (2304 + 64 * (j))
#define XB_TOP      3328
#define XB_TOPGEN   3392
#define XCD_BAR_WORDS 3456
#define XB_SPIN_CAP (1u << 18)

__device__ __forceinline__ unsigned xb_ld(unsigned* p)              { return __hip_atomic_load(p, __ATOMIC_RELAXED, __HIP_MEMORY_SCOPE_AGENT); }
__device__ __forceinline__ unsigned xb_add(unsigned* p, unsigned v) { return __hip_atomic_fetch_add(p, v, __ATOMIC_RELAXED, __HIP_MEMORY_SCOPE_AGENT); }
__device__ __forceinline__ unsigned xb_xcc_id() { return (unsigned)__builtin_amdgcn_s_getreg((3 << 11) | 20) & 0xFu; }
#define XB_SPIN(cond, bar) do { unsigned _sp = 0; while (cond) { __builtin_amdgcn_s_sleep(1); \
    if ((++_sp & 255u) == 0u) { if (xb_ld(&(bar)[XB_TMO])) break; if (_sp > XB_SPIN_CAP) { atomicAdd(&(bar)[XB_TMO], 1u); break; } } } } while (0)

struct XcdBarrier {
    unsigned* bar; unsigned x;
    volatile LAS unsigned* st;
};

__device__ __forceinline__ XcdBarrier xcd_barrier_post(unsigned* bar, volatile LAS unsigned* st) {
    XcdBarrier b; b.bar = bar; b.x = xb_xcc_id(); b.st = st;
    if (threadIdx.x == 0) (void)xb_add(&bar[XB_XCNT(b.x)], 1u);
    return b;
}
__device__ __forceinline__ void xcd_barrier_complete(unsigned* bar, unsigned x, unsigned& nloc, unsigned& nx) {
    const unsigned G = gridDim.x * gridDim.y * gridDim.z;
    unsigned sum, cnt, mine, sp = 0u;
    for (;;) {
        sum = 0u; cnt = 0u; mine = 0u;
#pragma unroll
        for (unsigned j = 0; j < 16; ++j) { const unsigned c = xb_ld(&bar[XB_XCNT(j)]); sum += c; cnt += (c > 0u) ? 1u : 0u; mine = (j == x) ? c : mine; }
        if (sum == G) break;
        __builtin_amdgcn_s_sleep(1);
        if ((++sp & 255u) == 0u) { if (xb_ld(&bar[XB_TMO])) break; if (sp > XB_SPIN_CAP) { atomicAdd(&bar[XB_TMO], 1u); break; } }
    }
    nloc = mine > 0u ? mine : 1u; nx = cnt > 0u ? cnt : 1u;
}

__device__ __forceinline__ void xcd_barrier(const XcdBarrier& b) {
    asm volatile("s_waitcnt vmcnt(0)" ::: "memory");
    __syncthreads();
    if (threadIdx.x == 0) {
        unsigned* bar = b.bar;
        __builtin_amdgcn_s_waitcnt(0);
        unsigned nloc = b.st[0], nx = b.st[1];
        if (nloc == 0u) { xcd_barrier_complete(bar, b.x, nloc, nx); b.st[0] = nloc; b.st[1] = nx; }
        const unsigned old = xb_add(&bar[XB_XSUB(b.x)], 1u);
        const unsigned gen = old / nloc;
        if (old + 1u == (gen + 1u) * nloc) {
            __builtin_amdgcn_fence(__ATOMIC_RELEASE, "agent");
            asm volatile("s_waitcnt vmcnt(0)" ::: "memory");
            const unsigned og = xb_add(&bar[XB_TOP], 1u);
            const unsigned tg = og / nx;
            if (og + 1u == (tg + 1u) * nx) xb_add(&bar[XB_TOPGEN], 1u);
            else XB_SPIN(xb_ld(&bar[XB_TOPGEN]) == tg, bar);
            __builtin_amdgcn_fence(__ATOMIC_ACQUIRE, "agent");
            xb_add(&bar[XB_XGEN(b.x)], 1u);
            asm volatile("s_waitcnt vmcnt(0)" ::: "memory");
        } else {
            XB_SPIN(xb_ld(&bar[XB_XGEN(b.x)]) == gen, bar);
            __builtin_amdgcn_fence(__ATOMIC_ACQUIRE, "agent");
            asm volatile("s_waitcnt vmcnt(0)" ::: "memory");
        }
    }
    __syncthreads();
}

constexpr int N_PHASES = 10;
#ifndef REP_P0
#define REP_P0 1
#endif
#ifndef REP_P2
#define REP_P2 1
#endif
#ifndef REP_CONV
#define REP_CONV 1
#endif
#ifndef REP_ATT
#define REP_ATT 1
#endif
#ifndef REP_P4
#define REP_P4 1
#endif
#ifndef REP_P7
#define REP_P7 1
#endif
#ifndef REP_N1
#define REP_N1 1
#endif
__global__ void __launch_bounds__(NTHR, 2) fwd_kernel(Args args) {
    extern __shared__ __attribute__((aligned(16))) unsigned char lds_raw[];
    LAS unsigned char* lds = (LAS unsigned char*)lds_raw;
    cg::grid_group grid = cg::this_grid();
#define TIDS int tid = threadIdx.x; asm volatile("" : "+v"(tid)); const int lane = tid & 63, wave = __builtin_amdgcn_readfirstlane(tid >> 6); (void)lane; (void)wave
    unsigned char* ws = args.ws;
    const int lo = args.ph_lo, hi = args.ph_hi;
    volatile LAS unsigned* bst = (volatile LAS unsigned*)(lds + LDS_BYTES - 64);
    if (threadIdx.x == 0) { bst[0] = 0u; bst[1] = 0u; }
    __syncthreads();
    const XcdBarrier xbar = xcd_barrier_post((unsigned*)(ws + WS_BAR), bst);
    const float* modall = (const float*)(ws + WS_MOD);
#define IN(k) (lo <= (k) && (k) < hi)
#define SEAM(k) do { if (IN(k) && IN((k) + 1)) xcd_barrier(xbar); } while (0)
    if (lo < 0) grid.sync();

#ifdef NANFILL
    if (IN(0)) {
        const size_t gt = (size_t)blockIdx.x * NTHR + threadIdx.x, GT = (size_t)gridDim.x * NTHR;
        u32x4* p = (u32x4*)(ws + NANFILL_LO); const size_t n = (NANFILL_HI - NANFILL_LO) / 16;
        for (size_t i = gt; i < n; i += GT) p[i] = (u32x4){0x7fc07fc0u, 0x7fc07fc0u, 0x7fc07fc0u, 0x7fc07fc0u};
#ifdef NANFILL_OUT
        u32x4* q = (u32x4*)((unsigned char*)args.out + 4 * MiB); const size_t nq = ((size_t)MT * DM * 4 - 4 * MiB) / 16;
        for (size_t i = gt; i < nq; i += GT) q[i] = (u32x4){0x7fc07fc0u, 0x7fc07fc0u, 0x7fc07fc0u, 0x7fc07fc0u};
#endif
    }
#endif
    if (IN(0)) for (int rep = 0; rep < REP_P0; ++rep) { TIDS; p0_prologue(args, lds, tid, lane, wave); __syncthreads(); }
    SEAM(0);
    if (IN(1)) {
        { int kdim = 256; asm volatile("" : "+s"(kdim));
          pg8::Gemm g{(const bf16*)args.out + (size_t)(LP + LS) * 256, (const bf16*)args.out, 2048, LP + LS, kdim}; pg8::StaticOrder S; S.init(2048, LP + LS, gridDim.x, (int)blockIdx.x);
          EpiTaps E{(unsigned short*)(ws + WS_TAPS)};
          pg8::gemm_phase<EpiTaps, pg8::StaticOrder, true, true>(lds, g, S, E); }
        TIDS;
        norm_rows<false>(args, nullptr, args.in[I_N1G], 0, 1024, ws + WS_H, lane, wave);
    }
    SEAM(1);
    if (IN(2)) {
        pg8::Gemm g{(const bf16*)(ws + WS_H), (const bf16*)(ws + WS_WIN), MT, NPROJ, DM}; pg8::StaticOrder S; S.init(MT, NPROJ, gridDim.x, (int)blockIdx.x);
        EpiProj E{(bf16*)(ws + WS_Q), (bf16*)(ws + WS_K), (bf16*)(ws + WS_VT), (bf16*)(ws + WS_UT), (bf16*)args.out};
#ifdef EPI2_P2
        EpiTwice E2{E};
        pg8::gemm_phase<EpiTwice, pg8::StaticOrder, true, true>(lds, g, S, E2);
#else
        pg8::gemm_phase<EpiProj, pg8::StaticOrder, true, true>(lds, g, S, E);
#endif
        if (REP_P2 == 2) { __syncthreads(); pg8::gemm_phase<EpiProj, pg8::StaticOrder, true, true>(lds, g, S, E); }
    }
    SEAM(2);
    if (IN(3)) {
        TIDS;
        for (int rep = 0; rep < REP_CONV; ++rep) for (int u = blockIdx.x; u < 1024; u += gridDim.x) { if (u < 512) conv_unit<true>(args, u, lds, tid); else conv_unit<false>(args, u - 512, lds, tid); }
        for (int rep = 0; rep < REP_ATT; ++rep) for (int u = blockIdx.x; u < 768; u += gridDim.x) attn_unit(args, u, lds, tid, lane, wave);
    }
    SEAM(3);
    if (IN(4)) {
        { TIDS; hy_transpose(args, lds, lane, wave); }
        xcd_barrier(xbar);
        pg8::DualOrder S; S.init(MT, DM, gridDim.x, (int)blockIdx.x);
        pg8::Gemm2 g{(const bf16*)(ws + WS_ATT), (const bf16*)(ws + WS_WAO), (const bf16*)(ws + WS_HY), (const bf16*)(ws + WS_WHO), MT, DM, HW};
        EpiMerge E{(bf16*)(ws + WS_H), (const bf16*)args.out};
        pg8::gemm_phase_dual<EpiMerge, pg8::DualOrder, true, true>(lds, g, S, E);
    }
    SEAM(4);
    if (IN(5)) {
        pg8::StaticOrder S; S.init(MT, DM, gridDim.x, (int)blockIdx.x);
        pg8::Gemm g{(const bf16*)(ws + WS_H), (const bf16*)(ws + WS_WOUT), MT, DM, DM};
        EpiGen<2> E{nullptr, nullptr, 0, args.out, nullptr, args.in[I_XP], args.in[I_XS], modall, 2048};
        pg8::gemm_phase<EpiGen<2>, pg8::StaticOrder, true, true>(lds, g, S, E);
    }
    SEAM(5);
#ifndef REP_N6
#define REP_N6 1
#endif
#ifndef EXTRA_SYNC
#define EXTRA_SYNC 0
#endif
    if (IN(6)) { TIDS; for (int rep = 0; rep < REP_N6; ++rep) norm_rows<false, true>(args, args.out, args.in[I_N2G], 3072, 4096, ws + WS_H, lane, wave);
                 for (int rep = 0; rep < EXTRA_SYNC; ++rep) xcd_barrier(xbar); }
    SEAM(6);
    if (IN(7)) {
        pg8::StaticOrder S; S.init(MT, FF, gridDim.x, (int)blockIdx.x);
        pg8::Gemm g{(const bf16*)(ws + WS_H), (const bf16*)(ws + WS_WUP), MT, FF, DM};
        EpiGen<3> E{(bf16*)(ws + WS_UP), nullptr, 0, nullptr, nullptr, nullptr, nullptr, nullptr, 0};
        pg8::gemm_phase<EpiGen<3>, pg8::StaticOrder, true, true>(lds, g, S, E);
        if (REP_P7 == 2) { __syncthreads(); pg8::gemm_phase<EpiGen<3>, pg8::StaticOrder, true, true>(lds, g, S, E); }
    }
    SEAM(7);
    if (IN(8)) {
        pg8::StaticOrder S; S.init(MT, DM, gridDim.x, (int)blockIdx.x);
        pg8::Gemm g{(const bf16*)(ws + WS_UP), (const bf16*)(ws + WS_WDN), MT, DM, FF};
        EpiGen<4> E{nullptr, nullptr, 0, (float*)(ws + WS_H), args.out, nullptr, nullptr, modall, 5120};
        pg8::gemm_phase<EpiGen<4>, pg8::StaticOrder, true, true>(lds, g, S, E);
    }
    SEAM(8);
    if (IN(9)) { TIDS; norm_rows<true, true>(args, (const float*)(ws + WS_H), args.in[I_FING], 6144, 7168, args.out, lane, wave); }
#undef IN
#undef SEAM
}

#ifndef N_LAUNCHES
#define N_LAUNCHES 1
#endif
extern "C" void kernel_launch(void* const* d_in, const int* in_sizes, int n_in, void* d_out, int out_size, void* d_ws, size_t ws_size, hipStream_t stream) {
    static int grid = 0;
    if (grid == 0) {
        if (n_in != 28 || out_size != MT * DM || ws_size < WS_END) { fprintf(stderr, "kernel_launch: unexpected shapes (n_in %d out %d ws %zu)\n", n_in, out_size, ws_size); grid = -1; return; }
        int dev = 0, cus = 0, per_cu = 0;
        hipGetDevice(&dev); hipDeviceGetAttribute(&cus, hipDeviceAttributeMultiprocessorCount, dev);
        if (hipFuncSetAttribute((const void*)fwd_kernel, hipFuncAttributeMaxDynamicSharedMemorySize, LDS_BYTES) != hipSuccess) { fprintf(stderr, "kernel_launch: hipFuncSetAttribute failed\n"); grid = -1; return; }
        if (hipOccupancyMaxActiveBlocksPerMultiprocessor(&per_cu, (const void*)fwd_kernel, NTHR, LDS_BYTES) != hipSuccess || per_cu < 1) { fprintf(stderr, "kernel_launch: occupancy query says %d\n", per_cu); per_cu = 1; }
        (void)hipGetLastError();
        grid = cus;
    }
    if (grid < 0) return;
    if (hipMemsetAsync((char*)d_ws + WS_BAR, 0, 16384, stream) != hipSuccess) { fprintf(stderr, "kernel_launch: hipMemsetAsync failed\n"); return; }
    Args a{};
    for (int i = 0; i < 28; ++i) a.in[i] = (const float*)d_in[i];
    a.out = (float*)d_out; a.ws = (unsigned char*)d_ws;
    for (int li = 0; li < N_LAUNCHES; ++li) {
        a.ph_lo = (N_LAUNCHES == 1) ? 0 : li; a.ph_hi = (N_LAUNCHES == 1) ? N_PHASES : li + 1;
        void* kargs[] = {&a};
        hipError_t e = hipLaunchCooperativeKernel((const void*)fwd_kernel, dim3(grid), dim3(NTHR), kargs, LDS_BYTES, stream);
        if (e != hipSuccess) { fprintf(stderr, "kernel_launch: cooperative launch %d failed: %s (grid %d)\n", li, hipGetErrorString(e), grid); break; }
    }
}
```
